# Optimizing an MI355X kernel written in HIP

```python
import jax
import jax.numpy as jnp
from jax import lax
import numpy as np

D_MODEL = 1024
BATCH = 16
SEQ = 2048
DEPTH = 1

N_MOD = 9
D_FF = 2816
EPS = 1e-6
ATT_GROUPS = ((128, 1), (512, 4), (2048, 16))
ATT_HEADS_PER_GROUP = 4
ATT_HEADS = ATT_HEADS_PER_GROUP * len(ATT_GROUPS)
ATT_HEAD_DIM = 64
ATT_WIDTH = ATT_HEADS * ATT_HEAD_DIM
ATT_OUT_WIDTH = ATT_HEADS_PER_GROUP * ATT_HEAD_DIM
ALIBI_MAX = 8.0
GLA_HEADS = 4
GLA_KEY_DIM = D_MODEL // 2
GLA_VAL_DIM = D_MODEL
GLA_DK = GLA_KEY_DIM // GLA_HEADS
GLA_DV = GLA_VAL_DIM // GLA_HEADS
GLA_GATE_RANK = 16
GLA_TAU = 16.0
GLA_CHUNK = 64
IN_SPLITS = (ATT_WIDTH, ATT_WIDTH, ATT_WIDTH, GLA_KEY_DIM, GLA_KEY_DIM, GLA_VAL_DIM, GLA_VAL_DIM, GLA_GATE_RANK, D_MODEL, D_MODEL)
IN_WIDTH = sum(IN_SPLITS)

kernel_name = 'hybrid_dilated_attn_gla_macaron_adaln'


def rms_norm(x, g):
    x32 = x.astype(jnp.float32)
    y = x32 * lax.rsqrt(jnp.mean(x32 * x32, axis=-1, keepdims=True) + EPS)
    return (y * g.astype(jnp.float32)).astype(x.dtype)


def modulate(h, shift, scale):
    return h * (1 + scale[:, None, :]) + shift[:, None, :]


def swiglu(u, w1, w3, w2):
    return (jax.nn.silu(u @ w1) * (u @ w3)) @ w2


def alibi_slopes(n):
    return 2.0 ** (-ALIBI_MAX * jnp.arange(1, n + 1, dtype=jnp.float32) / n)


def dilated_window_attention(q, k, v, slopes, window, dilation):
    B, S, H, Dh = q.shape
    blk = window // dilation
    L = S // dilation
    nb = -(-L // blk)
    pad = nb * blk - L

    def to_blocks(t):
        t = t.reshape(B, L, dilation, H, Dh)
        t = jnp.pad(t, ((0, 0), (0, pad), (0, 0), (0, 0), (0, 0)))
        return t.reshape(B, nb, blk, dilation, H, Dh)

    def band(t):
        prev = jnp.pad(t[:, :-1], ((0, 0), (1, 0), (0, 0), (0, 0), (0, 0), (0, 0)))
        return jnp.concatenate([prev, t], axis=2)

    qb = to_blocks(q)
    kk = band(to_blocks(k))
    vv = band(to_blocks(v))
    s = jnp.einsum('bnqrhd,bnkrhd->bnrhqk', qb, kk).astype(jnp.float32)
    qi = jnp.arange(blk)[:, None]
    kj = jnp.arange(2 * blk)[None, :]
    steps = qi + blk - kj
    valid = (steps >= 0) & (steps <= blk)
    valid = valid[None] & ~((jnp.arange(nb) == 0)[:, None, None] & (kj < blk)[None])
    bias = -(slopes * dilation)[:, None, None] * steps.astype(jnp.float32)
    s = jnp.where(valid[None, :, None, None], s + bias, -jnp.inf)
    m = jnp.max(s, axis=-1, keepdims=True)
    e = jnp.exp(s - m)
    den = jnp.sum(e, axis=-1, keepdims=True)
    p = (e / den).astype(v.dtype)
    lse = (m + jnp.log(den))[..., 0]
    o = jnp.einsum('bnrhqk,bnkrhd->bnqrhd', p, vv)
    o = o.reshape(B, nb * blk, dilation, H, Dh)[:, :L].reshape(B, S, H, Dh)
    lse = lse.transpose(0, 1, 4, 2, 3).reshape(B, nb * blk, dilation, H)[:, :L].reshape(B, S, H)
    return o, lse


def gla_chunked(q, k, v, log_a):
    B, S, H, Dk = q.shape
    Dv = v.shape[-1]
    C = GLA_CHUNK
    N = S // C

    def chunks(t):
        return t.astype(jnp.float32).reshape(B, N, C, H, t.shape[-1]).transpose(1, 0, 3, 2, 4)

    qc, kc, vc = chunks(q), chunks(k), chunks(v)
    bc = jnp.cumsum(chunks(log_a), axis=3)
    causal = jnp.tril(jnp.ones((C, C), dtype=bool))

    def step(state, inp):
        q_, k_, v_, b_ = inp
        b_last = b_[:, :, -1:, :]
        q_dec = q_ * jnp.exp(b_)
        attn = jnp.einsum('bhid,bhjd->bhij', q_dec, k_ * jnp.exp(-b_))
        attn = jnp.where(causal, attn, 0.0)
        o = jnp.einsum('bhij,bhjv->bhiv', attn, v_) + jnp.einsum('bhid,bhdv->bhiv', q_dec, state)
        state = (jnp.exp(b_last)[:, :, 0, :, None] * state
                 + jnp.einsum('bhjd,bhjv->bhdv', k_ * jnp.exp(b_last - b_), v_))
        return state, o

    state0 = jnp.zeros((B, H, Dk, Dv), jnp.float32)
    _, o = lax.scan(step, state0, (qc, kc, vc, bc))
    return o.transpose(1, 0, 3, 2, 4).reshape(B, S, H, Dv)


def token_mixing(u, w_in, q_norm_g, k_norm_g, gla_gate_up, gla_gate_bias, gla_out_norm_g,
                 w_branch_att, w_branch_gla, w_out):
    B, S, _ = u.shape
    split_points = [int(i) for i in np.cumsum(IN_SPLITS)[:-1]]
    (aq, ak, av, gq, gk, gv, gr, g_down, gate_att, gate_gla) = jnp.split(u @ w_in, split_points, axis=-1)

    aq = rms_norm(aq.reshape(B, S, ATT_HEADS, ATT_HEAD_DIM), q_norm_g) * (ATT_HEAD_DIM ** -0.5)
    ak = rms_norm(ak.reshape(B, S, ATT_HEADS, ATT_HEAD_DIM), k_norm_g)
    av = av.reshape(B, S, ATT_HEADS, ATT_HEAD_DIM)
    slopes = alibi_slopes(ATT_HEADS)
    outs, lses = [], []
    for gi, (window, dilation) in enumerate(ATT_GROUPS):
        hs = slice(gi * ATT_HEADS_PER_GROUP, (gi + 1) * ATT_HEADS_PER_GROUP)
        o_g, lse_g = dilated_window_attention(aq[:, :, hs], ak[:, :, hs], av[:, :, hs], slopes[hs], window, dilation)
        outs.append(o_g)
        lses.append(lse_g)
    mix_w = jax.nn.softmax(jnp.stack(lses), axis=0).astype(u.dtype)
    o_att = jnp.sum(mix_w[..., None] * jnp.stack(outs), axis=0).reshape(B, S, ATT_OUT_WIDTH)

    gq = gq.reshape(B, S, GLA_HEADS, GLA_DK) * (GLA_DK ** -0.5)
    gk = gk.reshape(B, S, GLA_HEADS, GLA_DK)
    gv = gv.reshape(B, S, GLA_HEADS, GLA_DV)
    log_a = jax.nn.log_sigmoid((g_down @ gla_gate_up + gla_gate_bias).astype(jnp.float32)) / GLA_TAU
    o_gla = gla_chunked(gq, gk, gv, log_a.reshape(B, S, GLA_HEADS, GLA_DK))
    o_gla = rms_norm(o_gla, gla_out_norm_g).astype(u.dtype) * jax.nn.silu(gr).reshape(B, S, GLA_HEADS, GLA_DV)
    o_gla = o_gla.reshape(B, S, GLA_VAL_DIM)

    merged = (jax.nn.sigmoid(gate_att) * (o_att @ w_branch_att)
              + jax.nn.sigmoid(gate_gla) * (o_gla @ w_branch_gla))
    return merged @ w_out


def setup_inputs(seed: int = 0) -> dict:
    key = jax.random.key(seed)
    ks = jax.random.split(key, 22)
    f32 = jnp.float32

    def nrm(k, shape, fan_in, scale=1.0):
        return jax.random.normal(k, shape, f32) * (scale * fan_in ** -0.5)

    def gain(k, shape):
        return 1.0 + 0.05 * jax.random.normal(k, shape, f32)

    return {
        'x': jax.random.normal(ks[0], (BATCH, SEQ, D_MODEL), f32),
        'c': jax.random.normal(ks[1], (BATCH, D_MODEL), f32),
        'w_mod': nrm(ks[2], (DEPTH, D_MODEL, N_MOD * D_MODEL), D_MODEL, 0.2),
        'b_mod': 0.01 * jax.random.normal(ks[3], (DEPTH, N_MOD * D_MODEL), f32),
        'g_ffn1': gain(ks[4], (DEPTH, D_MODEL)),
        'ffn1_w1': nrm(ks[5], (DEPTH, D_MODEL, D_FF), D_MODEL),
        'ffn1_w3': nrm(ks[6], (DEPTH, D_MODEL, D_FF), D_MODEL),
        'ffn1_w2': nrm(ks[7], (DEPTH, D_FF, D_MODEL), D_FF),
        'g_mix': gain(ks[8], (DEPTH, D_MODEL)),
        'w_in': nrm(ks[9], (DEPTH, D_MODEL, IN_WIDTH), D_MODEL),
        'q_norm_g': gain(ks[10], (DEPTH, ATT_HEAD_DIM)),
        'k_norm_g': gain(ks[11], (DEPTH, ATT_HEAD_DIM)),
        'gla_gate_up': nrm(ks[12], (DEPTH, GLA_GATE_RANK, GLA_KEY_DIM), GLA_GATE_RANK),
        'gla_gate_bias': 0.1 * jax.random.normal(ks[13], (DEPTH, GLA_KEY_DIM), f32),
        'gla_out_norm_g': gain(ks[14], (DEPTH, GLA_DV)),
        'w_branch_att': nrm(ks[15], (DEPTH, ATT_OUT_WIDTH, D_MODEL), ATT_OUT_WIDTH),
        'w_branch_gla': nrm(ks[16], (DEPTH, GLA_VAL_DIM, D_MODEL), GLA_VAL_DIM),
        'w_out': nrm(ks[17], (DEPTH, D_MODEL, D_MODEL), D_MODEL),
        'g_ffn2': gain(ks[18], (DEPTH, D_MODEL)),
        'ffn2_w1': nrm(ks[19], (DEPTH, D_MODEL, D_FF), D_MODEL),
        'ffn2_w3': nrm(ks[20], (DEPTH, D_MODEL, D_FF), D_MODEL),
        'ffn2_w2': nrm(ks[21], (DEPTH, D_FF, D_MODEL), D_FF),
    }


def reference(x, c, w_mod, b_mod, g_ffn1, ffn1_w1, ffn1_w3, ffn1_w2, g_mix, w_in, q_norm_g, k_norm_g,
              gla_gate_up, gla_gate_bias, gla_out_norm_g, w_branch_att, w_branch_gla, w_out,
              g_ffn2, ffn2_w1, ffn2_w3, ffn2_w2):
    h = x
    c_act = jax.nn.silu(c)
    for l in range(DEPTH):
        mod = c_act @ w_mod[l] + b_mod[l]
        (sh1, sc1, gt1, sh2, sc2, gt2, sh3, sc3, gt3) = jnp.split(mod, N_MOD, axis=-1)
        u = modulate(rms_norm(h, g_ffn1[l]), sh1, sc1)
        h = h + 0.5 * (1 + gt1)[:, None, :] * swiglu(u, ffn1_w1[l], ffn1_w3[l], ffn1_w2[l])
        u = modulate(rms_norm(h, g_mix[l]), sh2, sc2)
        h = h + (1 + gt2)[:, None, :] * token_mixing(u, w_in[l], q_norm_g[l], k_norm_g[l], gla_gate_up[l],
                                                     gla_gate_bias[l], gla_out_norm_g[l], w_branch_att[l],
                                                     w_branch_gla[l], w_out[l])
        u = modulate(rms_norm(h, g_ffn2[l]), sh3, sc3)
        h = h + 0.5 * (1 + gt3)[:, None, :] * swiglu(u, ffn2_w1[l], ffn2_w3[l], ffn2_w2[l])
    return h
```

```cpp
#include <hip/hip_runtime.h>
#include <type_traits>
#ifndef USE_CG_SYNC
#define USE_CG_SYNC 0
#endif
#include <hip/hip_cooperative_groups.h>
#include <cstdio>
#include <cstdint>
namespace cg = cooperative_groups;
namespace pg8 {
#define PG8_LAS __attribute__((address_space(3)))
typedef unsigned short bf16_t;
typedef short bf16x8 __attribute__((ext_vector_type(8)));
typedef float f32x4 __attribute__((ext_vector_type(4)));
typedef float f32x2 __attribute__((ext_vector_type(2)));
typedef unsigned u32x4 __attribute__((ext_vector_type(4)));
typedef unsigned u32x2 __attribute__((ext_vector_type(2)));
constexpr int BM = 256, BK = 64, HALF = 128, HTB = HALF * BK * 2, STAGE_BYTES = 8 * HTB, NXCD = 8, WGM = 8;

__host__ __device__ __forceinline__ int lds_byte(int r, int c) { const int st = (r >> 4) * 2 + (c >> 5), rr = r & 15, cc = c & 31, ob = rr * 64 + cc * 2; return st * 1024 + (ob ^ (((ob >> 9) & 1) << 5)); }
__host__ __device__ __forceinline__ void stage_rc(int b, int& R, int& C) { const int st = b / 1024, sb = b % 1024, swz = sb ^ (((sb >> 9) & 1) << 5); R = (st >> 1) * 16 + swz / 64; C = (st & 1) * 32 + (swz % 64) / 2; }
__host__ __device__ __forceinline__ int perm32(int rho) { const int n = rho >> 4, i = rho & 15; return 8 * (i >> 2) + 4 * n + (i & 3); }

struct Unit { int pm, pn; };
struct Gemm { const bf16_t* A; const bf16_t* Bt; int M, N, K, lda, ldb; int ablk; };

struct StaticOrder {
    int nM, nN, nwg, G, c;
    __device__ void init(int M, int N, int G_, int c_) { nM = M / BM; nN = N / BM; nwg = nM * nN; G = G_; c = c_; }
    __device__ bool next(int i, Unit& u) const {
        const long L = (long)i * G + c; if (L >= nwg) return false;
        int wgid = (int)L; { const int q = nwg / NXCD, r = nwg % NXCD, xcd = wgid % NXCD, off = wgid / NXCD; wgid = (xcd < r ? xcd * (q + 1) : r * (q + 1) + (xcd - r) * q) + off; }
        const int nig = WGM * nN, gid = wgid / nig, fm = gid * WGM, gsz = (nM - fm) < WGM ? (nM - fm) : WGM;
        u.pm = fm + ((wgid % nig) % gsz); u.pn = (wgid % nig) / gsz; return true;
    }
};

typedef __bf16 bf16x2_t __attribute__((ext_vector_type(2)));
__device__ __forceinline__ unsigned cvt_pk_bf16(float lo, float hi) { f32x2 v = {lo, hi}; bf16x2_t b = __builtin_convertvector(v, bf16x2_t); return __builtin_bit_cast(unsigned, b); }
__device__ __forceinline__ float bf_lo(unsigned w) { return __uint_as_float(w << 16); }
__device__ __forceinline__ float bf_hi(unsigned w) { return __uint_as_float(w & 0xffff0000u); }
__device__ __forceinline__ float fast_sigmoid(float x) { return __builtin_amdgcn_rcpf(1.0f + __builtin_amdgcn_exp2f(-1.4426950408889634f * x)); }

typedef f32x4 Acc[2][2][4][2];

struct EpiSwiGLU {
    static constexpr bool PERM = true; static constexpr int MIDK_T = 0, CMAP = 0;
    bf16_t* O; int ldc;
    __device__ __forceinline__ void mid(Acc&, const Unit&, int, int, int, int) const {}
    __device__ __forceinline__ void operator()(const Acc& acc, const Unit& u, int wr, int wc, int fr, int fq) const {
        const int kt = u.pn * 2 + (wc >> 1), c0 = (wc & 1) * 32 + 8 * fq, r0 = wr * 64 + fr;
        bf16_t* tile = O + ((size_t)(u.pm * (ldc >> 6) + kt) * BM + r0) * BK + c0;
#pragma unroll
        for (int ai = 0; ai < 2; ++ai)
#pragma unroll
            for (int m = 0; m < 4; ++m) {
                bf16_t* rowp = tile + (ai * HALF + m * 16) * BK;
                float r[8];
#pragma unroll
                for (int n = 0; n < 2; ++n)
#pragma unroll
                    for (int j = 0; j < 4; ++j) { const float g = acc[ai][0][m][n][j], up = acc[ai][1][m][n][j]; r[n * 4 + j] = g * fast_sigmoid(g) * up; }
                u32x4 w; w.x = cvt_pk_bf16(r[0], r[1]); w.y = cvt_pk_bf16(r[2], r[3]); w.z = cvt_pk_bf16(r[4], r[5]); w.w = cvt_pk_bf16(r[6], r[7]);
                *(u32x4*)rowp = w;
            }
    }
};
template <bool BASE_BF16, bool OUT_BF16> struct EpiResidual {
    static constexpr bool PERM = true; static constexpr int MIDK_T = 0, CMAP = 0;
    const void* base; void* out; const float* gt; float coef;
    __device__ __forceinline__ void mid(Acc&, const Unit&, int, int, int, int) const {}
    __device__ __forceinline__ void operator()(const Acc& acc, const Unit& u, int wr, int wc, int fr, int fq) const {
        const int row0 = u.pm * BM + wr * 64 + fr, col0 = u.pn * BM + wc * 32 + 8 * fq;
        const float* g = gt + (size_t)((u.pm * BM) >> 11) * 9216 + col0;
        f32x4 gv[2][2];
#pragma unroll
        for (int bj = 0; bj < 2; ++bj)
#pragma unroll
            for (int n = 0; n < 2; ++n) gv[bj][n] = (*(const f32x4*)(g + bj * HALF + 4 * n) + 1.0f) * coef;
#pragma unroll
        for (int ai = 0; ai < 2; ++ai)
#pragma unroll
            for (int m = 0; m < 4; ++m) { const size_t off = (size_t)(row0 + ai * HALF + m * 16) * 1024 + col0;
#pragma unroll
                for (int bj = 0; bj < 2; ++bj) {
                    f32x4 b0, b1;
                    if (BASE_BF16) { const u32x4 t = *(const u32x4*)((const bf16_t*)base + off + bj * HALF);
                        b0 = (f32x4){bf_lo(t.x), bf_hi(t.x), bf_lo(t.y), bf_hi(t.y)}; b1 = (f32x4){bf_lo(t.z), bf_hi(t.z), bf_lo(t.w), bf_hi(t.w)}; }
                    else { b0 = *(const f32x4*)((const float*)base + off + bj * HALF); b1 = *(const f32x4*)((const float*)base + off + bj * HALF + 4); }
                    const f32x4 o0 = b0 + gv[bj][0] * acc[ai][bj][m][0], o1 = b1 + gv[bj][1] * acc[ai][bj][m][1];
                    if (OUT_BF16) { u32x4 w; w.x = cvt_pk_bf16(o0[0], o0[1]); w.y = cvt_pk_bf16(o0[2], o0[3]); w.z = cvt_pk_bf16(o1[0], o1[1]); w.w = cvt_pk_bf16(o1[2], o1[3]);
                        *(u32x4*)((bf16_t*)out + off + bj * HALF) = w; }
                    else { *(f32x4*)((float*)out + off + bj * HALF) = o0; *(f32x4*)((float*)out + off + bj * HALF + 4) = o1; } }
                if (m == 3) asm volatile("" ::: "memory"); }
    }
};
__device__ __forceinline__ u32x4 xchg8(u32x4 v) { u32x4 r;
    r.x = (unsigned)__builtin_amdgcn_update_dpp(0, (int)v.x, 0x128, 0xf, 0xf, false); r.y = (unsigned)__builtin_amdgcn_update_dpp(0, (int)v.y, 0x128, 0xf, 0xf, false);
    r.z = (unsigned)__builtin_amdgcn_update_dpp(0, (int)v.z, 0x128, 0xf, 0xf, false); r.w = (unsigned)__builtin_amdgcn_update_dpp(0, (int)v.w, 0x128, 0xf, 0xf, false); return r; }
struct EpiProj {
    static constexpr bool PERM = true; static constexpr int MIDK_T = 0, CMAP = 1;
    bf16_t *Q, *KV, *GB, *GR, *GD; const float* qg; const float* kg;
    __device__ __forceinline__ void mid(Acc&, const Unit&, int, int, int, int) const {}
    __device__ __forceinline__ void operator()(const Acc& acc, const Unit& u, int wr, int wc, int fr, int fq) const {
        bf16_t* base; int ldc, colt;
        const bool kvt = u.pn >= 3 && u.pn < 9;
        if (u.pn < 9) { base = Q; ldc = 768; colt = u.pn * 256; }
        else if (u.pn < 17) { base = GB; ldc = 2048; colt = (u.pn - 9) * 256; }
        else if (u.pn < 21) { base = GR; ldc = 1024; colt = (u.pn - 17) * 256; }
        else { base = GD; ldc = 256; colt = 0; }
        const bool lo = fr < 8;
        const int rowb = u.pm * BM + wr * 64 + (fr & 7), col = colt + wc * 64 + (lo ? 0 : 32) + 8 * fq;
        const bool nrm = u.pn < 3 || (u.pn < 9 && !(wc & 1));
        f32x4 gn[2][2];
        if (nrm) { const float* gp = (u.pn < 3 ? qg : kg) + 8 * fq; const float sc = (u.pn < 3) ? 0.125f * 1.4426950408889634f : 1.0f;
#pragma unroll
            for (int bj = 0; bj < 2; ++bj)
#pragma unroll
                for (int n = 0; n < 2; ++n) gn[bj][n] = *(const f32x4*)(gp + 32 * bj + 4 * n) * sc; }
#pragma unroll
        for (int ai = 0; ai < 2; ++ai)
#pragma unroll
            for (int m = 0; m < 4; ++m) {
                f32x4 v[2][2];
#pragma unroll
                for (int bj = 0; bj < 2; ++bj) { v[bj][0] = acc[ai][bj][m][0]; v[bj][1] = acc[ai][bj][m][1]; }
                if (nrm) { float ss = 0.f;
#pragma unroll
                    for (int bj = 0; bj < 2; ++bj)
#pragma unroll
                        for (int n = 0; n < 2; ++n) ss += (v[bj][n][0] * v[bj][n][0] + v[bj][n][1] * v[bj][n][1]) + (v[bj][n][2] * v[bj][n][2] + v[bj][n][3] * v[bj][n][3]);
                    ss += __shfl_xor(ss, 16); ss += __shfl_xor(ss, 32);
                    const float rstd = 1.0f / sqrtf(ss * (1.0f / 64.0f) + 1e-6f);
#pragma unroll
                    for (int bj = 0; bj < 2; ++bj)
#pragma unroll
                        for (int n = 0; n < 2; ++n) v[bj][n] = v[bj][n] * rstd * gn[bj][n]; }
                u32x4 w[2];
#pragma unroll
                for (int bj = 0; bj < 2; ++bj) { w[bj].x = cvt_pk_bf16(v[bj][0][0], v[bj][0][1]); w[bj].y = cvt_pk_bf16(v[bj][0][2], v[bj][0][3]); w[bj].z = cvt_pk_bf16(v[bj][1][0], v[bj][1][1]); w[bj].w = cvt_pk_bf16(v[bj][1][2], v[bj][1][3]); }
                u32x4 snd; snd.x = lo ? w[1].x : w[0].x; snd.y = lo ? w[1].y : w[0].y; snd.z = lo ? w[1].z : w[0].z; snd.w = lo ? w[1].w : w[0].w;
                const u32x4 rcv = xchg8(snd);
                u32x4 pa, pb; pa.x = lo ? w[0].x : rcv.x; pa.y = lo ? w[0].y : rcv.y; pa.z = lo ? w[0].z : rcv.z; pa.w = lo ? w[0].w : rcv.w;
                pb.x = lo ? rcv.x : w[1].x; pb.y = lo ? rcv.y : w[1].y; pb.z = lo ? rcv.z : w[1].z; pb.w = lo ? rcv.w : w[1].w;
                const int R = rowb + ai * HALF + m * 16;
                if (kvt) { const int hh = (u.pn - 3) * 2 + (wc >> 1), ld2 = 2 * (hh >> 2), dm = (1 << ld2) - 1, t0 = R & 2047, t1 = t0 + 8;
                    bf16_t* hb = KV + ((size_t)((R >> 11) * 12 + hh) * 2048) * 128 + (wc & 1) * 64 + (lo ? 0 : 32) + 8 * fq;
                    *(u32x4*)(hb + (size_t)(((t0 & dm) << (11 - ld2)) + (t0 >> ld2)) * 128) = pa; *(u32x4*)(hb + (size_t)(((t1 & dm) << (11 - ld2)) + (t1 >> ld2)) * 128) = pb; }
                else { bf16_t* rowp = base + (size_t)R * ldc + col;
                    *(u32x4*)rowp = pa; *(u32x4*)(rowp + (size_t)8 * ldc) = pb; } }
    }
};
template <int ACT> struct EpiBf16 {
    static constexpr bool PERM = true; static constexpr int MIDK_T = 0, CMAP = 0;
    bf16_t* O; int ldc;
    __device__ __forceinline__ void mid(Acc&, const Unit&, int, int, int, int) const {}
    __device__ __forceinline__ void operator()(const Acc& acc, const Unit& u, int wr, int wc, int fr, int fq) const {
        const int row0 = u.pm * BM + wr * 64 + fr, col0 = u.pn * BM + wc * 32 + 8 * fq;
#pragma unroll
        for (int ai = 0; ai < 2; ++ai)
#pragma unroll
            for (int m = 0; m < 4; ++m) { bf16_t* rowp = O + (size_t)(row0 + ai * HALF + m * 16) * ldc + col0;
#pragma unroll
                for (int bj = 0; bj < 2; ++bj) { f32x4 v0 = acc[ai][bj][m][0], v1 = acc[ai][bj][m][1];
                    if (ACT == 1) {
#pragma unroll
                        for (int j = 0; j < 4; ++j) { v0[j] = fast_sigmoid(v0[j]); v1[j] = fast_sigmoid(v1[j]); } }
                    u32x4 w; w.x = cvt_pk_bf16(v0[0], v0[1]); w.y = cvt_pk_bf16(v0[2], v0[3]); w.z = cvt_pk_bf16(v1[0], v1[1]); w.w = cvt_pk_bf16(v1[2], v1[3]);
                    *(u32x4*)(rowp + bj * HALF) = w; } }
    }
};
struct EpiGates {
    static constexpr bool PERM = true; static constexpr int MIDK_T = 0, CMAP = 0;
    bf16_t* SA; bf16_t* SGG;
    __device__ __forceinline__ void mid(Acc&, const Unit&, int, int, int, int) const {}
    __device__ __forceinline__ void operator()(const Acc& acc, const Unit& u, int wr, int wc, int fr, int fq) const {
        bf16_t* O = (u.pn < 4) ? SA : SGG; const int ldc = 1024;
        const int row0 = u.pm * BM + wr * 64 + fr, col0 = (u.pn & 3) * BM + wc * 32 + 8 * fq;
#pragma unroll
        for (int ai = 0; ai < 2; ++ai)
#pragma unroll
            for (int m = 0; m < 4; ++m) { bf16_t* rowp = O + (size_t)(row0 + ai * HALF + m * 16) * ldc + col0;
#pragma unroll
                for (int bj = 0; bj < 2; ++bj) { f32x4 v0 = acc[ai][bj][m][0], v1 = acc[ai][bj][m][1];
#pragma unroll
                    for (int j = 0; j < 4; ++j) { v0[j] = fast_sigmoid(v0[j]); v1[j] = fast_sigmoid(v1[j]); }
                    u32x4 w; w.x = cvt_pk_bf16(v0[0], v0[1]); w.y = cvt_pk_bf16(v0[2], v0[3]); w.z = cvt_pk_bf16(v1[0], v1[1]); w.w = cvt_pk_bf16(v1[2], v1[3]);
                    *(u32x4*)(rowp + bj * HALF) = w; } }
    }
};
struct EpiBranch {
    static constexpr bool PERM = true; static constexpr int MIDK_T = 4, CMAP = 0;
    const bf16_t* SA; const bf16_t* SGG; bf16_t* O;
    __device__ __forceinline__ void mid(Acc& acc, const Unit& u, int wr, int wc, int fr, int fq) const {
        int row0 = u.pm * BM + wr * 64 + fr, col0 = u.pn * BM + wc * 32 + 8 * fq;
        asm volatile("" : "+v"(row0), "+v"(col0));
#pragma unroll
        for (int ai = 0; ai < 2; ++ai)
#pragma unroll
            for (int m = 0; m < 4; ++m) { const size_t r = (size_t)(row0 + ai * HALF + m * 16);
#pragma unroll
                for (int bj = 0; bj < 2; ++bj) { const u32x4 a = *(const u32x4*)(SA + r * 1024 + col0 + bj * HALF), g = *(const u32x4*)(SGG + r * 1024 + col0 + bj * HALF);
                    f32x4 r0, r1;
                    { r0[0] = bf_lo(a.x) * __builtin_amdgcn_rcpf(bf_lo(g.x)); r0[1] = bf_hi(a.x) * __builtin_amdgcn_rcpf(bf_hi(g.x));
                    r0[2] = bf_lo(a.y) * __builtin_amdgcn_rcpf(bf_lo(g.y)); r0[3] = bf_hi(a.y) * __builtin_amdgcn_rcpf(bf_hi(g.y));
                    r1[0] = bf_lo(a.z) * __builtin_amdgcn_rcpf(bf_lo(g.z)); r1[1] = bf_hi(a.z) * __builtin_amdgcn_rcpf(bf_hi(g.z));
                    r1[2] = bf_lo(a.w) * __builtin_amdgcn_rcpf(bf_lo(g.w)); r1[3] = bf_hi(a.w) * __builtin_amdgcn_rcpf(bf_hi(g.w)); }
                    acc[ai][bj][m][0] *= r0; acc[ai][bj][m][1] *= r1; }
                if (m == 3) asm volatile("" ::: "memory"); }
    }
    __device__ __forceinline__ void operator()(const Acc& acc, const Unit& u, int wr, int wc, int fr, int fq) const {
        const int row0 = u.pm * BM + wr * 64 + fr, col0 = u.pn * BM + wc * 32 + 8 * fq;
#pragma unroll
        for (int ai = 0; ai < 2; ++ai)
#pragma unroll
            for (int m = 0; m < 4; ++m) { const size_t r = (size_t)(row0 + ai * HALF + m * 16);
#pragma unroll
                for (int bj = 0; bj < 2; ++bj) { const u32x4 g = *(const u32x4*)(SGG + r * 1024 + col0 + bj * HALF);
                    f32x4 v0 = acc[ai][bj][m][0], v1 = acc[ai][bj][m][1];
                    u32x4 w; w.x = cvt_pk_bf16(v0[0] * bf_lo(g.x), v0[1] * bf_hi(g.x)); w.y = cvt_pk_bf16(v0[2] * bf_lo(g.y), v0[3] * bf_hi(g.y));
                    w.z = cvt_pk_bf16(v1[0] * bf_lo(g.z), v1[1] * bf_hi(g.z)); w.w = cvt_pk_bf16(v1[2] * bf_lo(g.w), v1[3] * bf_hi(g.w));
                    *(u32x4*)(O + r * 1024 + col0 + bj * HALF) = w; }
                if (m == 3) asm volatile("" ::: "memory"); }
    }
};


template <class Epi, class Sched>
__device__ __forceinline__ void gemm_phase(PG8_LAS unsigned char* lds, const Gemm g, const Sched& S, const Epi& E, const int wave_id  ) {
    int lane_ = __builtin_amdgcn_mbcnt_hi(~0u, __builtin_amdgcn_mbcnt_lo(~0u, 0u)); asm volatile("" : "+v"(lane_));
    const int wid = wave_id, lane = lane_, tid = wid * 64 + lane, wr = wid >> 2, wc = wid & 3, fr = lane & 15, fq = lane >> 4;
    const int K = g.K, nt = K / BK, lda = g.lda, ldb = g.ldb;
    unsigned voffA[2], voffB[2];
#pragma unroll
    for (int i = 0; i < 2; ++i) { int R, C; stage_rc(tid * 16 + i * 8192, R, C); const int Rb = Epi::PERM ? (Epi::CMAP ? (64 * (R >> 5) + perm32(R & 31)) : ((R & ~31) + perm32(R & 31))) : R;
        voffA[i] = (unsigned)(R * (g.ablk ? BK : lda) + C) * 2u; voffB[i] = (unsigned)(Rb * ldb + C) * 2u; }
    const size_t kstep = (size_t)(BK * 2), kstepA = g.ablk ? (size_t)(BM * BK * 2) : kstep;
    const size_t hstepA = g.ablk ? (size_t)(HALF * BK * 2) : (size_t)HALF * lda * 2, hstepB = (size_t)(Epi::CMAP ? 32 : HALF) * ldb * 2;
    const size_t tstepA = g.ablk ? (size_t)nt * kstepA : 2 * hstepA, tstepB = (size_t)BM * ldb * 2;
    const unsigned ldsw = (unsigned)wid * 1024u;
    const int aoff = lds_byte(wr * 64 + fr, fq * 8), boff = lds_byte(wc * 32 + fr, fq * 8);
#define PG8_SA(b, h) (((b) * 2 + (h)) * HTB)
#define PG8_SB(b, h) ((4 + (b) * 2 + (h)) * HTB)
#define PG8_STAGE(bufoff, gbase, voff) do { _Pragma("unroll") for (int _i = 0; _i < 2; ++_i) \
        __builtin_amdgcn_global_load_lds((const unsigned*)((const char*)(gbase) + (voff)[_i]), (PG8_LAS unsigned*)(lds + (bufoff) + ldsw + _i * 8192), 16, 0, 0); } while (0)
#define PG8_LDA(dst, b, h) do { _Pragma("unroll") for (int m = 0; m < 4; ++m) _Pragma("unroll") for (int k = 0; k < 2; ++k) dst[m][k] = *(const PG8_LAS bf16x8*)(lds + PG8_SA(b, h) + aoff + m * 2048 + k * 1024); } while (0)
#define PG8_LDB(dst, b, h) do { _Pragma("unroll") for (int n = 0; n < 2; ++n) _Pragma("unroll") for (int k = 0; k < 2; ++k) dst[n][k] = *(const PG8_LAS bf16x8*)(lds + PG8_SB(b, h) + boff + n * 2048 + k * 1024); } while (0)
#define PG8_MMA(ai, bj, At, Bt) do { __builtin_amdgcn_s_setprio(1); _Pragma("unroll") for (int m = 0; m < 4; ++m) _Pragma("unroll") for (int n = 0; n < 2; ++n) _Pragma("unroll") for (int k = 0; k < 2; ++k) \
        acc[ai][bj][m][n] = __builtin_amdgcn_mfma_f32_16x16x32_bf16(Bt[n][k], At[m][k], acc[ai][bj][m][n], 0, 0, 0); __builtin_amdgcn_s_setprio(0); } while (0)
#define PG8_WAIT_V(n) asm volatile("s_waitcnt vmcnt(" #n ")" ::: "memory")
#define PG8_WAIT_L(n) asm volatile("s_waitcnt lgkmcnt(" #n ")" ::: "memory")
#define PG8_BAR __builtin_amdgcn_s_barrier()
#define PG8_SCHED __builtin_amdgcn_sched_barrier(0)
    Unit cur, nxt; int ui = 0;
    if (!S.next(0, cur)) return;
    Acc acc;
#pragma unroll
    for (int a = 0; a < 2; ++a)
#pragma unroll
        for (int b = 0; b < 2; ++b)
#pragma unroll
            for (int m = 0; m < 4; ++m)
#pragma unroll
                for (int n = 0; n < 2; ++n) acc[a][b][m][n] = (f32x4){0.f, 0.f, 0.f, 0.f};
    bf16x8 At[4][2], B0[2][2], B1[2][2];
    const char* cA = (const char*)g.A + (size_t)cur.pm * tstepA; const char* cB = (const char*)g.Bt + (size_t)cur.pn * tstepB;
    PG8_STAGE(PG8_SB(0, 0), cB, voffB); PG8_STAGE(PG8_SB(0, 1), cB + hstepB, voffB); PG8_STAGE(PG8_SA(0, 0), cA, voffA); PG8_STAGE(PG8_SA(0, 1), cA + hstepA, voffA);
    if (wr == 1) PG8_BAR;
    PG8_WAIT_V(2); PG8_BAR;
    PG8_STAGE(PG8_SB(1, 0), cB + kstep, voffB); PG8_STAGE(PG8_SA(1, 0), cA + kstepA, voffA); PG8_STAGE(PG8_SB(1, 1), cB + hstepB + kstep, voffB);
    PG8_WAIT_V(6); PG8_BAR;
    for (;;) {
        const bool has_next = S.next(ui + 1, nxt);
        const char* nA = has_next ? (const char*)g.A + (size_t)nxt.pm * tstepA : cA; const char* nB = has_next ? (const char*)g.Bt + (size_t)nxt.pn * tstepB : cB;
        for (int t = 0; t < nt; t += 2) {
            const bool last = (t == nt - 2);
            const char* a1 = cA + (size_t)(t + 1) * kstepA;
            const char* a2 = last ? nA : cA + (size_t)(t + 2) * kstepA; const char* b2 = last ? nB : cB + (size_t)(t + 2) * kstep;
            const char* a3 = a2 + kstepA; const char* b3 = b2 + kstep;
            PG8_LDB(B0, 0, 0); PG8_LDB(B1, 0, 1); PG8_SCHED; PG8_LDA(At, 0, 0); PG8_STAGE(PG8_SA(1, 1), a1 + hstepA, voffA);
            PG8_WAIT_V(8); PG8_WAIT_L(0); PG8_BAR; PG8_MMA(0, 0, At, B0); PG8_MMA(0, 1, At, B1); PG8_BAR; PG8_SCHED;
            PG8_LDA(At, 0, 1); PG8_STAGE(PG8_SB(0, 0), b2, voffB); PG8_STAGE(PG8_SB(0, 1), b2 + hstepB, voffB); PG8_STAGE(PG8_SA(0, 0), a2, voffA);
            PG8_WAIT_V(8); PG8_WAIT_L(0); PG8_BAR; PG8_MMA(1, 0, At, B0); PG8_MMA(1, 1, At, B1); PG8_BAR; PG8_SCHED;
            PG8_LDB(B0, 1, 0); PG8_LDB(B1, 1, 1); PG8_SCHED; PG8_LDA(At, 1, 0); PG8_STAGE(PG8_SA(0, 1), a2 + hstepA, voffA);
            PG8_WAIT_V(8); PG8_WAIT_L(0); PG8_BAR; PG8_MMA(0, 0, At, B0); PG8_MMA(0, 1, At, B1); PG8_BAR; PG8_SCHED;
            PG8_LDA(At, 1, 1); PG8_STAGE(PG8_SB(1, 0), b3, voffB); PG8_STAGE(PG8_SB(1, 1), b3 + hstepB, voffB); PG8_STAGE(PG8_SA(1, 0), a3, voffA);
            PG8_WAIT_V(8); PG8_WAIT_L(0); PG8_BAR; PG8_MMA(1, 0, At, B0); PG8_MMA(1, 1, At, B1); PG8_BAR; PG8_SCHED;
            if constexpr (Epi::MIDK_T > 0) { if (t + 2 == Epi::MIDK_T) { E.mid(acc, cur, wr, wc, fr, fq); PG8_SCHED; } }
        }
        if (wr == 0) PG8_BAR;
        E(acc, cur, wr, wc, fr, fq);
        if (!has_next) break;
#pragma unroll
        for (int a = 0; a < 2; ++a)
#pragma unroll
            for (int b = 0; b < 2; ++b)
#pragma unroll
                for (int m = 0; m < 4; ++m)
#pragma unroll
                    for (int n = 0; n < 2; ++n) acc[a][b][m][n] = (f32x4){0.f, 0.f, 0.f, 0.f};
        cur = nxt; cA = nA; cB = nB; ++ui;
        if (wr == 1) PG8_BAR;
    }
    PG8_WAIT_V(0);
    PG8_BAR;
#undef PG8_SA
#undef PG8_SB
#undef PG8_STAGE
#undef PG8_LDA
#undef PG8_LDB
#undef PG8_MMA
#undef PG8_WAIT_V
#undef PG8_WAIT_L
#undef PG8_BAR
#undef PG8_SCHED
}
}
#define GAS __attribute__((address_space(1)))
#define LAS __attribute__((address_space(3)))
typedef unsigned short bf16;
typedef unsigned v4u __attribute__((ext_vector_type(4)));
typedef unsigned v2u __attribute__((ext_vector_type(2)));
typedef float f32x4 __attribute__((ext_vector_type(4)));
typedef short bf16x8 __attribute__((ext_vector_type(8)));
#define LDS_WAIT() asm volatile("s_waitcnt lgkmcnt(0)" ::: "memory")

constexpr int NWAVES = 8, NTHREADS = 512;
constexpr int BATCH = 16, SEQ = 2048, D = 1024, T = BATCH * SEQ, DFF = 2816, NMOD = 9;
constexpr int IN_W = 7440, N_PROJ1 = 5632, N_GATES = 2048, N_IN_PAD = 7680;
constexpr float EPS = 1e-6f;
constexpr size_t MiB = 1u << 20;
constexpr size_t WS_CTL = 0;
constexpr size_t WS_MOD = 1 * MiB;
constexpr size_t WS_W13_1 = 2 * MiB;
constexpr size_t WS_W2_1 = 13 * MiB;
constexpr size_t WS_WIN = 19 * MiB;
constexpr size_t WS_WB = 34 * MiB;
constexpr size_t WS_WOUT = 37 * MiB;
constexpr size_t WS_W13_2 = 39 * MiB;
constexpr size_t WS_W2_2 = 50 * MiB;
constexpr size_t WS_LSE = 56 * MiB;
constexpr size_t WS_SSQ = 58 * MiB;
constexpr size_t WS_GD = 66 * MiB;
constexpr size_t WS_U = 82 * MiB;
constexpr size_t WS_BIG = 146 * MiB;
constexpr size_t WS_HACT = WS_BIG;
constexpr size_t WS_Q = WS_BIG;
constexpr size_t WS_KV = WS_BIG + 48 * MiB;
constexpr size_t WS_GB = 290 * MiB;
constexpr size_t WS_GR = 418 * MiB;
constexpr size_t WS_EBL = 482 * MiB;
constexpr size_t WS_END = 483 * MiB;
static_assert(WS_KV + (size_t)T * 12 * 128 * 2 <= WS_GB && WS_Q + (size_t)T * 768 * 2 <= WS_KV && WS_GB + (size_t)T * 2048 * 2 <= WS_GR && WS_W2_2 + (size_t)1024 * 2816 * 2 <= WS_LSE && WS_HACT + (size_t)T * DFF * 2 <= 512 * MiB && WS_END <= 512 * MiB, "ws map");

__device__ __forceinline__ unsigned f2bf(float f) { unsigned u = __builtin_bit_cast(unsigned, f); return (u + 0x7fffu + ((u >> 16) & 1u)) >> 16; }
__device__ __forceinline__ unsigned pk2(float lo, float hi) { return pg8::cvt_pk_bf16(lo, hi); }
__device__ __forceinline__ float bflo(unsigned w) { return __uint_as_float(w << 16); }
__device__ __forceinline__ float bfhi(unsigned w) { return __uint_as_float(w & 0xffff0000u); }
__device__ __forceinline__ float wave_sum(float v) {
#pragma unroll
    for (int o = 1; o < 64; o <<= 1) v += __shfl_xor(v, o);
    return v;
}

struct Args { const float* in[22]; float* out; unsigned char* ws; int ph_lo, ph_hi; };
#define PHASE_LOCAL(F) do { int l_ = __builtin_amdgcn_mbcnt_hi(~0u, __builtin_amdgcn_mbcnt_lo(~0u, 0u)); asm volatile("" : "+v"(l_)); (F).lane = l_; (F).tid = (F).wave * 64 + l_; } while (0)
struct Frame {
    LAS unsigned char* lds;
    int tid, lane, wave, vcu, G;
    const float* const* in; float* out; unsigned char* ws;
};
enum { I_X = 0, I_C, I_WMOD, I_BMOD, I_GFFN1, I_F1W1, I_F1W3, I_F1W2, I_GMIX, I_WIN, I_QNG, I_KNG, I_GUP, I_GBIAS, I_GONG, I_WBA, I_WBG, I_WOUT, I_GFFN2, I_F2W1, I_F2W3, I_F2W2 };

__device__ __forceinline__ void transpose_item(const float* W, int ldsrc, int k0, int nsrc0, int nvalid, bf16* dst, int drow0, int ldd, int dcol0, LAS float* scr, int lane) {
    const int n4 = 4 * (lane & 7);
    f32x4 tv[8];
#pragma unroll
    for (int i = 0; i < 8; ++i) { const int kk = 8 * i + (lane >> 3); tv[i] = (n4 < nvalid) ? *(const f32x4*)(W + (size_t)(k0 + kk) * ldsrc + nsrc0 + n4) : (f32x4){0.f, 0.f, 0.f, 0.f}; }
#pragma unroll
    for (int i = 0; i < 8; ++i) { const int kk = 8 * i + (lane >> 3); LAS float* sp = scr + kk * 33 + n4; sp[0] = tv[i][0]; sp[1] = tv[i][1]; sp[2] = tv[i][2]; sp[3] = tv[i][3]; }
    LDS_WAIT(); asm volatile("" ::: "memory");
    const int c = lane & 7;
#pragma unroll
    for (int jj = 0; jj < 4; ++jj) { const int n = (lane >> 3) + 8 * jj; const LAS float* s = scr + (8 * c) * 33 + n;
        v4u o; o.x = pk2(s[0 * 33], s[1 * 33]); o.y = pk2(s[2 * 33], s[3 * 33]); o.z = pk2(s[4 * 33], s[5 * 33]); o.w = pk2(s[6 * 33], s[7 * 33]);
        if (n < nvalid) *(GAS v4u*)(dst + (size_t)(drow0 + n) * ldd + dcol0 + k0 + 8 * c) = o; }
    LDS_WAIT(); asm volatile("" ::: "memory");
}
constexpr int FFN_ITEMS = 3 * 1408;
__device__ __forceinline__ void ffn_weight_item(const float* w1, const float* w3, const float* w2, bf16* W13, bf16* W2, int r, LAS float* scr, int lane) {
    if (r < 2816) { const int which = r / 1408, q = r % 1408, kb = q / 88, nb = q % 88, n0 = nb * 32;
        transpose_item(which ? w3 : w1, DFF, kb * 64, n0, 32, W13, (n0 >> 7) * 256 + (n0 & 127) + which * 128, 1024, 0, scr, lane); }
    else { const int q = r - 2816, kb = q / 32, nb = q % 32; transpose_item(w2, D, kb * 64, nb * 32, 32, W2, nb * 32, DFF, 0, scr, lane); }
}
__device__ __forceinline__ void p0_prologue(Frame& F) {
    PHASE_LOCAL(F);
    LAS float* scr = (LAS float*)(F.lds + F.wave * 16384);
    const int gw = F.vcu * NWAVES + F.wave, NGW = F.G * NWAVES;
    bf16* W13_1 = (bf16*)(F.ws + WS_W13_1); bf16* W2_1 = (bf16*)(F.ws + WS_W2_1); bf16* WIN = (bf16*)(F.ws + WS_WIN); bf16* WB = (bf16*)(F.ws + WS_WB);
    bf16* WOUT = (bf16*)(F.ws + WS_WOUT); bf16* W13_2 = (bf16*)(F.ws + WS_W13_2); bf16* W2_2 = (bf16*)(F.ws + WS_W2_2);
    constexpr int I_IN = 16 * (168 + 1 + 64), I_BA = 4 * 32, I_BG = 16 * 32, I_OUT = 16 * 32, I_PAD = 240;
    constexpr int NITEMS = 2 * FFN_ITEMS + I_IN + I_BA + I_BG + I_OUT + I_PAD;
    const bool bal = F.G == 256, modwg = F.vcu < 144;
    const int nslots = !bal ? 1 : modwg ? 3 : 6, sbase = !bal ? gw : modwg ? gw * 3 : 144 * NWAVES * 3 + (gw - 144 * NWAVES) * 6;
    const int NSLOTS = bal ? 144 * NWAVES * 3 + 112 * NWAVES * 6 : NGW;
    for (int ks = 0; ks < nslots; ++ks)
    for (int it = sbase + ks; it < NITEMS; it += NSLOTS) {
        int r = it;
        if (r < FFN_ITEMS) { ffn_weight_item(F.in[I_F1W1], F.in[I_F1W3], F.in[I_F1W2], W13_1, W2_1, r, scr, F.lane); continue; } r -= FFN_ITEMS;
        if (r < FFN_ITEMS) { ffn_weight_item(F.in[I_F2W1], F.in[I_F2W3], F.in[I_F2W2], W13_2, W2_2, r, scr, F.lane); continue; } r -= FFN_ITEMS;
        if (r < I_IN) { const int kb = r / 233, nb = r % 233;
            if (nb < 168) { int drow = nb * 32;
                if (drow >= 768 && drow < 1536) drow = 768 + ((drow - 768) >> 6) * 128 + ((drow - 768) & 63);
                else if (drow >= 1536 && drow < 2304) drow = 768 + ((drow - 1536) >> 6) * 128 + 64 + ((drow - 1536) & 63);
                transpose_item(F.in[I_WIN], IN_W, kb * 64, nb * 32, 32, WIN, drow, 1024, 0, scr, F.lane); }
            else if (nb == 168) transpose_item(F.in[I_WIN], IN_W, kb * 64, 5376, 16, WIN, 5376, 1024, 0, scr, F.lane);
            else transpose_item(F.in[I_WIN], IN_W, kb * 64, 5392 + (nb - 169) * 32, 32, WIN, N_PROJ1 + (nb - 169) * 32, 1024, 0, scr, F.lane);
            continue; } r -= I_IN;
        if (r < I_BA) { const int kb = r / 32, nb = r % 32; transpose_item(F.in[I_WBA], D, kb * 64, nb * 32, 32, WB, nb * 32, 1280, 0, scr, F.lane); continue; } r -= I_BA;
        if (r < I_BG) { const int kb = r / 32, nb = r % 32; transpose_item(F.in[I_WBG], D, kb * 64, nb * 32, 32, WB, nb * 32, 1280, 256, scr, F.lane); continue; } r -= I_BG;
        if (r < I_OUT) { const int kb = r / 32, nb = r % 32; transpose_item(F.in[I_WOUT], D, kb * 64, nb * 32, 32, WOUT, nb * 32, 1024, 0, scr, F.lane); continue; } r -= I_OUT;
        { GAS v4u* row = (GAS v4u*)(WIN + (size_t)(5392 + r) * 1024); const v4u z = {0u, 0u, 0u, 0u}; row[F.lane] = z; row[64 + F.lane] = z; }
    }
}
__device__ __forceinline__ void p0_mod(Frame& F) {
    __syncthreads();
    if (F.vcu < 144) {
        LAS float* cat = (LAS float*)F.lds;
        LAS float* red = (LAS float*)(F.lds + 65536);
        const float* c = F.in[I_C];
        {   float cv[32];
#pragma unroll
            for (int i = 0; i < 32; ++i) cv[i] = c[F.tid + NTHREADS * i];
#pragma unroll
            for (int i = 0; i < 32; ++i) { const int e = F.tid + NTHREADS * i; cat[(e & 1023) * 16 + (e >> 10)] = cv[i] / (1.f + __expf(-cv[i])); } }
        __syncthreads();
        const int n4 = F.lane & 15, bg = F.lane >> 4, kb = F.wave * 128;
        const float* w = F.in[I_WMOD] + F.vcu * 64 + 4 * n4;
        f32x4 acc[4];
#pragma unroll
        for (int bi = 0; bi < 4; ++bi) acc[bi] = (f32x4){0.f, 0.f, 0.f, 0.f};
        f32x4 wv[2][16];
#pragma unroll
        for (int i = 0; i < 16; ++i) wv[0][i] = *(const f32x4*)(w + (size_t)(kb + i) * (NMOD * D));
#pragma unroll
        for (int gi = 0; gi < 8; ++gi) { const int k0 = 16 * gi;
            if (gi < 7) {
#pragma unroll
                for (int i = 0; i < 16; ++i) wv[(gi + 1) & 1][i] = *(const f32x4*)(w + (size_t)(kb + k0 + 16 + i) * (NMOD * D)); }
#pragma unroll
            for (int i = 0; i < 16; ++i) { const f32x4 cb = *(const LAS f32x4*)(cat + (kb + k0 + i) * 16 + 4 * bg);
#pragma unroll
                for (int bi = 0; bi < 4; ++bi) acc[bi] += wv[gi & 1][i] * cb[bi]; } }
#pragma unroll
        for (int bi = 0; bi < 4; ++bi) *(LAS f32x4*)(red + (F.wave * 16 + 4 * bg + bi) * 64 + 4 * n4) = acc[bi];
        __syncthreads();
        float* mod = (float*)(F.ws + WS_MOD);
        for (int i = F.tid; i < 16 * 64; i += NTHREADS) { const int b = i >> 6, l = i & 63; float s = 0.f;
#pragma unroll
            for (int wv = 0; wv < 8; ++wv) s += red[(wv * 16 + b) * 64 + l];
            mod[b * (NMOD * D) + F.vcu * 64 + l] = s + F.in[I_BMOD][F.vcu * 64 + l]; }
    }
}
template <bool IN_BF16> __device__ __forceinline__ void norm_phase(Frame& F, const void* X, const float* g, int sh_idx, bf16* U) {
    PHASE_LOCAL(F);
    const int gw = F.vcu * NWAVES + F.wave;
    const int row0 = gw * 16, b = row0 >> 11;
    const float* mod = (const float*)(F.ws + WS_MOD) + (size_t)b * (NMOD * D);
    f32x4 gam[4], shv[4];
#pragma unroll
    for (int j = 0; j < 4; ++j) { const int col = 8 * F.lane + 512 * (j >> 1) + 4 * (j & 1); const f32x4 gg = *(const f32x4*)(g + col), sc = *(const f32x4*)(mod + (sh_idx + 1) * D + col);
        gam[j] = gg * (sc + 1.0f); shv[j] = *(const f32x4*)(mod + sh_idx * D + col); }
    typedef typename std::conditional<IN_BF16, v4u, f32x4>::type raw_t;
    constexpr int NRAW = IN_BF16 ? 2 : 4;
    raw_t raw[2][4][NRAW];
#define NP_LOAD(buf, r0) do { _Pragma("unroll") for (int rr = 0; rr < 4; ++rr) { \
        if (IN_BF16) { const GAS v4u* xr = (const GAS v4u*)((const bf16*)X + (size_t)(row0 + (r0) + rr) * D) + F.lane; \
            _Pragma("unroll") for (int h2 = 0; h2 < 2; ++h2) raw[buf][rr][h2] = __builtin_bit_cast(raw_t, xr[64 * h2]); } \
        else { const GAS f32x4* xr = (const GAS f32x4*)((const float*)X + (size_t)(row0 + (r0) + rr) * D) + 2 * F.lane; \
            _Pragma("unroll") for (int h2 = 0; h2 < 2; ++h2) { raw[buf][rr][(2 * h2) % NRAW] = __builtin_bit_cast(raw_t, xr[128 * h2]); raw[buf][rr][(2 * h2 + 1) % NRAW] = __builtin_bit_cast(raw_t, xr[128 * h2 + 1]); } } } } while (0)
    NP_LOAD(0, 0);
#pragma unroll
    for (int gi = 0; gi < 4; ++gi) {
        if (gi < 3) NP_LOAD((gi + 1) & 1, 4 * (gi + 1));
#pragma unroll
        for (int rr = 0; rr < 4; ++rr) { const int r = 4 * gi + rr;
            f32x4 v[4]; float s = 0.f;
            if (IN_BF16) {
#pragma unroll
                for (int h2 = 0; h2 < 2; ++h2) { const v4u t = __builtin_bit_cast(v4u, raw[gi & 1][rr][h2 % NRAW]);
                    v[2 * h2] = (f32x4){bflo(t.x), bfhi(t.x), bflo(t.y), bfhi(t.y)}; v[2 * h2 + 1] = (f32x4){bflo(t.z), bfhi(t.z), bflo(t.w), bfhi(t.w)}; } }
            else {
#pragma unroll
                for (int j = 0; j < 4; ++j) v[j] = __builtin_bit_cast(f32x4, raw[gi & 1][rr][j % NRAW]); }
#pragma unroll
            for (int j = 0; j < 4; ++j) s += (v[j].x * v[j].x + v[j].y * v[j].y) + (v[j].z * v[j].z + v[j].w * v[j].w);
            const float rstd = 1.f / sqrtf(wave_sum(s) * (1.f / D) + EPS);
            GAS v4u* o16 = (GAS v4u*)(U + (size_t)(row0 + r) * D) + F.lane;
#pragma unroll
            for (int h2 = 0; h2 < 2; ++h2) { const f32x4 y0 = v[2 * h2] * rstd * gam[2 * h2] + shv[2 * h2], y1 = v[2 * h2 + 1] * rstd * gam[2 * h2 + 1] + shv[2 * h2 + 1];
                v4u w; w.x = pk2(y0.x, y0.y); w.y = pk2(y0.z, y0.w); w.z = pk2(y1.x, y1.y); w.w = pk2(y1.z, y1.w); o16[64 * h2] = w; }
        }
    }
#undef NP_LOAD
}
#define XB_TMO      128
#define XB_XCNT(j)  (256  + 64 * (j))
#define XB_XSUB(j)  (1280 + 64 * (j))
#define XB_XGEN(j)  (2304 + 64 * (j))
#define XB_TOP      3328
#define XB_TOPGEN   3392
#define XCD_BAR_WORDS 3456
#define XB_SPIN_CAP (1u << 22)
__device__ __forceinline__ unsigned xb_ld(unsigned* p)              { return __hip_atomic_load(p, __ATOMIC_RELAXED, __HIP_MEMORY_SCOPE_AGENT); }
__device__ __forceinline__ unsigned xb_add(unsigned* p, unsigned v) { return __hip_atomic_fetch_add(p, v, __ATOMIC_RELAXED, __HIP_MEMORY_SCOPE_AGENT); }
__device__ __forceinline__ unsigned xb_xcc_id() { return (unsigned)__builtin_amdgcn_s_getreg((3 << 11) | 20) & 0xFu; }
#define XB_SPIN(cond, bar) do { unsigned _sp = 0; while (cond) { __builtin_amdgcn_s_sleep(1); \
    if ((++_sp & 255u) == 0u) { if (xb_ld(&(bar)[XB_TMO])) break; if (_sp > XB_SPIN_CAP) { atomicAdd(&(bar)[XB_TMO], 1u); break; } } } } while (0)
struct XcdBarrier { unsigned* bar; unsigned x; volatile LAS unsigned* st; };
__device__ __forceinline__ XcdBarrier xcd_barrier_post(unsigned* bar, volatile LAS unsigned* st, bool leader) {
    XcdBarrier b; b.bar = bar; b.x = xb_xcc_id(); b.st = st;
    if (leader) (void)xb_add(&bar[XB_XCNT(b.x)], 1u);
    return b;
}
__device__ __forceinline__ void xcd_barrier_complete(unsigned* bar, unsigned x, unsigned& nloc, unsigned& nx) {
    const unsigned G = gridDim.x;
    unsigned sum, cnt, mine, sp = 0u;
    for (;;) {
        sum = 0u; cnt = 0u; mine = 0u;
#pragma unroll
        for (unsigned j = 0; j < 16; ++j) { const unsigned c = xb_ld(&bar[XB_XCNT(j)]); sum += c; cnt += (c > 0u) ? 1u : 0u; mine = (j == x) ? c : mine; }
        if (sum == G) break;
        __builtin_amdgcn_s_sleep(1);
        if ((++sp & 255u) == 0u) { if (xb_ld(&bar[XB_TMO])) break; if (sp > XB_SPIN_CAP) { atomicAdd(&bar[XB_TMO], 1u); break; } }
    }
    nloc = mine > 0u ? mine : 1u; nx = cnt > 0u ? cnt : 1u;
}
__device__ __forceinline__ void xcd_barrier(const XcdBarrier& b, bool leader  ) {
    asm volatile("s_waitcnt vmcnt(0)" ::: "memory");
    __syncthreads();
    if (leader) {
        unsigned* bar = b.bar;
        __builtin_amdgcn_s_waitcnt(0);
        unsigned nloc = b.st[0], nx = b.st[1];
        if (nloc == 0u) { xcd_barrier_complete(bar, b.x, nloc, nx); b.st[0] = nloc; b.st[1] = nx; }
        const unsigned old = xb_add(&bar[XB_XSUB(b.x)], 1u);
        const unsigned gen = old / nloc;
        if (old + 1u == (gen + 1u) * nloc) {
            __builtin_amdgcn_fence(__ATOMIC_RELEASE, "agent");
            asm volatile("s_waitcnt vmcnt(0)" ::: "memory");
            const unsigned og = xb_add(&bar[XB_TOP], 1u);
            const unsigned tg = og / nx;
            if (og + 1u == (tg + 1u) * nx) xb_add(&bar[XB_TOPGEN], 1u);
            else XB_SPIN(xb_ld(&bar[XB_TOPGEN]) == tg, bar);
            __builtin_amdgcn_fence(__ATOMIC_ACQUIRE, "agent");
            xb_add(&bar[XB_XGEN(b.x)], 1u);
            asm volatile("s_waitcnt vmcnt(0)" ::: "memory");
        } else {
            XB_SPIN(xb_ld(&bar[XB_XGEN(b.x)]) == gen, bar);
            __builtin_amdgcn_fence(__ATOMIC_ACQUIRE, "agent");
            asm volatile("s_waitcnt vmcnt(0)" ::: "memory");
        }
    }
    __syncthreads();
}
typedef float f32x16 __attribute__((ext_vector_type(16)));
typedef short s16x4 __attribute__((ext_vector_type(4)));
typedef short v4i16_t __attribute__((ext_vector_type(4)));
constexpr float LOG2E = 1.4426950408889634f, LN2 = 0.6931471805599453f;
__device__ __forceinline__ s16x4 lds_tr(LAS const unsigned char* p) { return __builtin_bit_cast(s16x4, __builtin_amdgcn_ds_read_tr16_b64_v4i16((LAS v4i16_t*)p)); }
__device__ __forceinline__ bf16x8 cat44(s16x4 a, s16x4 b) { return (bf16x8){a[0], a[1], a[2], a[3], b[0], b[1], b[2], b[3]}; }
#define DPP_SHR(x, n) __builtin_bit_cast(float, __builtin_amdgcn_update_dpp(0, __builtin_bit_cast(int, (x)), 0x110 + (n), 0xf, 0xf, false))

template <bool DRY> __device__ __forceinline__ void gla_prep(Frame& F) {
    PHASE_LOCAL(F);
    const int w = F.wave, lane = F.lane, t15 = lane & 15, g = lane >> 4;
    bf16* GB = (bf16*)(F.ws + WS_GB); const bf16* GD = (const bf16*)(F.ws + WS_GD); float* EBL = (float*)(F.ws + WS_EBL);
    const int h = (F.vcu >> 5) & 3;
    bf16x8 gupA = (bf16x8){0, 0, 0, 0, 0, 0, 0, 0};
    if (g < 2) { const float* gu = F.in[I_GUP] + h * 128 + 16 * w + t15;
#pragma unroll
        for (int jj = 0; jj < 8; ++jj) gupA[jj] = (short)f2bf(gu[(size_t)(8 * g + jj) * 512]); }
    float zb[4];
#pragma unroll
    for (int j = 0; j < 4; ++j) zb[j] = F.in[I_GBIAS][h * 128 + 16 * w + 4 * g + j];
    v4u rawq[2], rawk[2]; v4u gdf[4];
#define GP_LOAD(item_) do { const int bh_ = (item_) >> 5, c_ = (item_) & 31; const size_t r0_ = (size_t)(bh_ >> 2) * SEQ + c_ * 64; \
        _Pragma("unroll") for (int pp = 0; pp < 2; ++pp) { const bf16* rp = GB + (r0_ + 16 * (2 * pp + (g & 1)) + t15) * 2048 + h * 128 + 16 * w + 8 * (g >> 1); \
            rawq[pp] = *(const v4u*)rp; rawk[pp] = *(const v4u*)(rp + 512); } \
        _Pragma("unroll") for (int ti = 0; ti < 4; ++ti) { const size_t tr_ = r0_ + 16 * ti + t15; \
            gdf[ti] = (g < 2) ? *(const v4u*)(GD + tr_ * 256 + 8 * g) : (v4u){0u, 0u, 0u, 0u}; } } while (0)
    GP_LOAD(F.vcu);
    for (int it = 0; it < 8; ++it) {
        const int item = F.vcu + 256 * it, bh = item >> 5, c = item & 31, b = bh >> 2;
        const size_t row0 = (size_t)b * SEQ + c * 64;
        v2u qf[4], kf[4];
#pragma unroll
        for (int pp = 0; pp < 2; ++pp) {
            const auto qx = __builtin_amdgcn_permlane16_swap(rawq[pp].x, rawq[pp].z, false, false), qy = __builtin_amdgcn_permlane16_swap(rawq[pp].y, rawq[pp].w, false, false);
            const auto kx = __builtin_amdgcn_permlane16_swap(rawk[pp].x, rawk[pp].z, false, false), ky = __builtin_amdgcn_permlane16_swap(rawk[pp].y, rawk[pp].w, false, false);
            qf[2 * pp] = (v2u){qx[0], qy[0]}; qf[2 * pp + 1] = (v2u){qx[1], qy[1]}; kf[2 * pp] = (v2u){kx[0], ky[0]}; kf[2 * pp + 1] = (v2u){kx[1], ky[1]}; }
        float bq[4][4];
#pragma unroll
        for (int ti = 0; ti < 4; ++ti) {
            pg8::f32x4 z = __builtin_amdgcn_mfma_f32_16x16x32_bf16(gupA, __builtin_bit_cast(bf16x8, gdf[ti]), (pg8::f32x4){0.f, 0.f, 0.f, 0.f}, 0, 0, 0);
#pragma unroll
            for (int j = 0; j < 4; ++j) { const float zz = z[j] + zb[j];
                float x = (fminf(zz, 0.f) * LOG2E - __builtin_amdgcn_logf(1.f + __builtin_amdgcn_exp2f(-fabsf(zz) * LOG2E))) * (1.f / 16.f);
                x += DPP_SHR(x, 1); x += DPP_SHR(x, 2); x += DPP_SHR(x, 4); x += DPP_SHR(x, 8);
                bq[ti][j] = x; }
        }
        float bl[4];
#pragma unroll
        for (int j = 0; j < 4; ++j) { float carry = 0.f;
#pragma unroll
            for (int ti = 0; ti < 4; ++ti) { const float tot = __shfl(bq[ti][j], (lane & 48) | 15); bq[ti][j] += carry; carry += tot; }
            bl[j] = carry; }
        v2u oq[4], ok[4];
#pragma unroll
        for (int ti = 0; ti < 4; ++ti) {
            const float q0 = bflo(qf[ti].x), q1 = bfhi(qf[ti].x), q2 = bflo(qf[ti].y), q3 = bfhi(qf[ti].y);
            const float k0 = bflo(kf[ti].x), k1 = bfhi(kf[ti].x), k2 = bflo(kf[ti].y), k3 = bfhi(kf[ti].y);
            float e[4], ei[4];
#pragma unroll
            for (int j = 0; j < 4; ++j) { e[j] = __builtin_amdgcn_exp2f(bq[ti][j]) * 0.08838834764831845f; ei[j] = __builtin_amdgcn_exp2f(-bq[ti][j]); }
            oq[ti].x = pg8::cvt_pk_bf16(q0 * e[0], q1 * e[1]); oq[ti].y = pg8::cvt_pk_bf16(q2 * e[2], q3 * e[3]);
            ok[ti].x = pg8::cvt_pk_bf16(k0 * ei[0], k1 * ei[1]); ok[ti].y = pg8::cvt_pk_bf16(k2 * ei[2], k3 * ei[3]);
        }
        if (it < 7) GP_LOAD(item + 256);
        if (DRY) {
#pragma unroll
            for (int ti = 0; ti < 4; ++ti) asm volatile("" :: "v"(oq[ti].x), "v"(oq[ti].y), "v"(ok[ti].x), "v"(ok[ti].y));
            asm volatile("" :: "v"(bl[0]), "v"(bl[1]), "v"(bl[2]), "v"(bl[3])); continue; }
#pragma unroll
        for (int pp = 0; pp < 2; ++pp) {
            const auto qx = __builtin_amdgcn_permlane16_swap(oq[2 * pp].x, oq[2 * pp + 1].x, false, false), qy = __builtin_amdgcn_permlane16_swap(oq[2 * pp].y, oq[2 * pp + 1].y, false, false);
            const auto kx = __builtin_amdgcn_permlane16_swap(ok[2 * pp].x, ok[2 * pp + 1].x, false, false), ky = __builtin_amdgcn_permlane16_swap(ok[2 * pp].y, ok[2 * pp + 1].y, false, false);
            bf16* rp = GB + (row0 + 16 * (2 * pp + (g & 1)) + t15) * 2048 + h * 128 + 16 * w + 8 * (g >> 1);
            *(v4u*)rp = (v4u){qx[0], qy[0], qx[1], qy[1]}; *(v4u*)(rp + 512) = (v4u){kx[0], ky[0], kx[1], ky[1]}; }
        if (t15 == 0) { f32x4 ev; ev[0] = __builtin_amdgcn_exp2f(bl[0]); ev[1] = __builtin_amdgcn_exp2f(bl[1]); ev[2] = __builtin_amdgcn_exp2f(bl[2]); ev[3] = __builtin_amdgcn_exp2f(bl[3]);
            *(f32x4*)(EBL + (size_t)item * 128 + 16 * w + 4 * g) = ev; }
    }
#undef GP_LOAD
}
#define LDS_BARRIER() do { asm volatile("s_waitcnt lgkmcnt(0)" ::: "memory"); __builtin_amdgcn_s_barrier(); asm volatile("" ::: "memory"); } while (0)
constexpr int G2_QD = 0, G2_KI = 34816, G2_V = 69632, G2_ST = 88064, G2_OB = 122880, G2_SS = 141312;
template <bool DRY> __device__ __forceinline__ void gla_chain2(Frame& F) {
    PHASE_LOCAL(F);
    const int w = F.wave, lane = F.lane, t15 = lane & 15, g = lane >> 4, tid = F.tid;
    const int bh = F.vcu >> 2, b = bh >> 2, h = bh & 3, sl = F.vcu & 3;
    LAS unsigned char* lds = F.lds;
    bf16* GB = (bf16*)(F.ws + WS_GB); float* SSQ = (float*)(F.ws + WS_SSQ); const float* EBL = (const float*)(F.ws + WS_EBL) + (size_t)bh * 32 * 128;
    const size_t row0 = (size_t)b * SEQ;
    v4u sqA[2], skA[2], svA, sqB[2], skB[2], svB; f32x4 ebA, ebB;
#define G2_LOAD(c, sq, sk, sv, ebn) do { const int c_ = (c); \
        _Pragma("unroll") for (int i = 0; i < 2; ++i) { const int p = tid + 512 * i; const bf16* rp = GB + (row0 + c_ * 64 + (p >> 4)) * 2048 + h * 128 + (p & 15) * 8; sq[i] = *(const v4u*)rp; sk[i] = *(const v4u*)(rp + 512); } \
        sv = *(const v4u*)(GB + (row0 + c_ * 64 + (tid >> 3)) * 2048 + 1024 + h * 256 + 64 * sl + 8 * (tid & 7)); \
        ebn = *(const f32x4*)(EBL + c_ * 128 + 16 * w + 4 * g); } while (0)
#define G2_STORE(buf, sq, sk, sv) do { const int b_ = (buf); \
        _Pragma("unroll") for (int i = 0; i < 2; ++i) { const int p = tid + 512 * i; *(LAS v4u*)(lds + G2_QD + b_ * 17408 + (p >> 4) * 272 + (p & 15) * 16) = sq[i]; *(LAS v4u*)(lds + G2_KI + b_ * 17408 + (p >> 4) * 272 + (p & 15) * 16) = sk[i]; } \
        *(LAS v4u*)(lds + G2_V + b_ * 9216 + (tid >> 3) * 144 + (tid & 7) * 16) = sv; } while (0)
#define G2_FLUSH(c, buf) do { if (!DRY) { const int c_ = (c), o_ = (buf); const size_t tr_ = row0 + c_ * 64 + (tid >> 3); \
        *(v4u*)(GB + tr_ * 2048 + 1024 + h * 256 + 64 * sl + 8 * (tid & 7)) = *(const LAS v4u*)(lds + G2_OB + o_ * 9216 + (tid >> 3) * 144 + (tid & 7) * 16); \
        if (tid < 64) *(f32x4*)(SSQ + (row0 + c_ * 64 + tid) * 64 + h * 16 + sl * 4) = *(const LAS f32x4*)(lds + G2_SS + o_ * 1024 + tid * 16); } } while (0)
    pg8::f32x4 acc[4];
#pragma unroll
    for (int i = 0; i < 4; ++i) acc[i] = (pg8::f32x4){0.f, 0.f, 0.f, 0.f};
    G2_LOAD(0, sqA, skA, svA, ebA); G2_STORE(0, sqA, skA, svA);
    f32x4 ebc = ebA;
#pragma unroll
    for (int dvt = 0; dvt < 4; ++dvt) *(LAS v2u*)(lds + G2_ST + (16 * dvt + t15) * 272 + (16 * w + 4 * g) * 2) = (v2u){0u, 0u};
    G2_LOAD(1, sqA, skA, svA, ebA); G2_LOAD(2, sqB, skB, svB, ebB);
    __syncthreads();
    const int tt = (w < 4) ? w : 7 - w, dvh = w >> 2;
    for (int c2 = 0; c2 < 32; c2 += 2) {
#pragma unroll
        for (int par = 0; par < 2; ++par) {
            const int c = c2 + par;
        const int bb = c & 1, qd = G2_QD + bb * 17408, ki = G2_KI + bb * 17408, vb = G2_V + bb * 9216, st = G2_ST + bb * 17408, stn = G2_ST + (bb ^ 1) * 17408;
            if (c > 0) G2_FLUSH(c - 1, bb ^ 1);
            {
                bf16x8 qf[4];
#pragma unroll
                for (int ks = 0; ks < 4; ++ks) qf[ks] = *(const LAS bf16x8*)(lds + qd + (16 * tt + t15) * 272 + (32 * ks + 8 * g) * 2);
                v2u ap[4];
#pragma unroll
                for (int tj = 0; tj < 4; ++tj) {
                    pg8::f32x4 d = (pg8::f32x4){0.f, 0.f, 0.f, 0.f};
                    if (tj <= tt) {
#pragma unroll
                        for (int ks = 0; ks < 4; ++ks) {
                            const bf16x8 a = *(const LAS bf16x8*)(lds + ki + (16 * tj + t15) * 272 + (32 * ks + 8 * g) * 2);
                            d = __builtin_amdgcn_mfma_f32_16x16x32_bf16(a, qf[ks], d, 0, 0, 0); }
                        if (tj == tt) {
#pragma unroll
                            for (int j = 0; j < 4; ++j) if (4 * g + j > t15) d[j] = 0.f; }
                    }
                    ap[tj].x = pk2(d[0], d[1]); ap[tj].y = pk2(d[2], d[3]); }
#pragma unroll
                for (int dd = 0; dd < 2; ++dd) { const int dvo = 2 * dvh + dd;
                    pg8::f32x4 d = (pg8::f32x4){0.f, 0.f, 0.f, 0.f};
#pragma unroll
                    for (int ks = 0; ks < 4; ++ks) {
                        const bf16x8 a = *(const LAS bf16x8*)(lds + st + (16 * dvo + t15) * 272 + (32 * ks + 8 * g) * 2);
                        d = __builtin_amdgcn_mfma_f32_16x16x32_bf16(a, qf[ks], d, 0, 0, 0); }
#pragma unroll
                    for (int ks = 0; ks < 2; ++ks) {
                        if (ks == 1 && tt < 2) continue;
                        LAS const unsigned char* va = lds + vb + (32 * ks + 4 * g + (t15 >> 2)) * 144 + (16 * dvo + 4 * (lane & 3)) * 2;
                        const bf16x8 a = cat44(lds_tr(va), lds_tr(va + 16 * 144));
                        const v4u bw = {ap[2 * ks].x, ap[2 * ks].y, ap[2 * ks + 1].x, ap[2 * ks + 1].y};
                        d = __builtin_amdgcn_mfma_f32_16x16x32_bf16(a, __builtin_bit_cast(bf16x8, bw), d, 0, 0, 0); }
                    v2u o; o.x = pk2(d[0], d[1]); o.y = pk2(d[2], d[3]);
                    float ss = (d[0] * d[0] + d[1] * d[1]) + (d[2] * d[2] + d[3] * d[3]);
                    ss += __shfl_xor(ss, 16); ss += __shfl_xor(ss, 32);
                    *(LAS v2u*)(lds + G2_OB + bb * 9216 + (16 * tt + t15) * 144 + (16 * dvo + 4 * g) * 2) = o;
                    if (g == 0) *(LAS float*)(lds + G2_SS + bb * 1024 + ((16 * tt + t15) * 4 + dvo) * 4) = ss; }
            }
#pragma unroll
            for (int ks = 0; ks < 2; ++ks) {
                const int trow = 32 * ks + 8 * g + (t15 >> 2);
                LAS const unsigned char* ka = lds + ki + trow * 272 + (16 * w + 4 * (lane & 3)) * 2;
                const bf16x8 a = cat44(lds_tr(ka), lds_tr(ka + 4 * 272));
#pragma unroll
                for (int dvt = 0; dvt < 4; ++dvt) { LAS const unsigned char* va = lds + vb + trow * 144 + (16 * dvt + 4 * (lane & 3)) * 2;
                    const bf16x8 bbf = cat44(lds_tr(va), lds_tr(va + 4 * 144));
                    acc[dvt] = __builtin_amdgcn_mfma_f32_16x16x32_bf16(a, bbf, acc[dvt], 0, 0, 0); }
            }
#pragma unroll
            for (int dvt = 0; dvt < 4; ++dvt) {
#pragma unroll
                for (int j = 0; j < 4; ++j) acc[dvt][j] *= ebc[j];
                v2u o; o.x = pk2(acc[dvt][0], acc[dvt][1]); o.y = pk2(acc[dvt][2], acc[dvt][3]);
                *(LAS v2u*)(lds + stn + (16 * dvt + t15) * 272 + (16 * w + 4 * g) * 2) = o; }
            if (par == 0) { G2_STORE(bb ^ 1, sqA, skA, svA); ebc = ebA; G2_LOAD(c < 29 ? c + 3 : 31, sqA, skA, svA, ebA); }
            else { G2_STORE(bb ^ 1, sqB, skB, svB); ebc = ebB; G2_LOAD(c < 29 ? c + 3 : 31, sqB, skB, svB, ebB); }
            LDS_BARRIER();
        }
    }
    G2_FLUSH(31, 1);
#undef G2_LOAD
#undef G2_STORE
#undef G2_FLUSH
}
constexpr int AT_TAB = 131072;
template <bool DRY> __device__ __forceinline__ void attn_units(Frame& F) {
    PHASE_LOCAL(F);
    const int tid = F.tid, lane = F.lane, w = F.wave, half = w >> 2, hw = w & 3, r32 = lane & 31, hi = lane >> 5;
    LAS unsigned char* lds = F.lds;
    bf16* Q = (bf16*)(F.ws + WS_Q); const bf16* KV = (const bf16*)(F.ws + WS_KV); float* LSE = (float*)(F.ws + WS_LSE);
    LAS unsigned char* Kb = lds + half * 65536; LAS unsigned char* Vb = Kb + 32768;
    const int ht = tid & 255, qi = 32 * hw + r32, a0 = hw >> 1;
#define AT_DECODE(it_) const int bu_ = 2 * (F.vcu + 256 * (it_)) + half, idx16_ = bu_ & 15, bhh_ = bu_ >> 4, b_ = bhh_ / 12, h_ = bhh_ % 12, gi_ = h_ >> 2, dil_ = 1 << (2 * gi_), \
        r_ = idx16_ & (dil_ - 1), n_ = idx16_ >> (2 * gi_); const size_t row0_ = (size_t)b_ * SEQ
    v4u kv[8], vv[8], qv[4];
    const int rsub = ht >> 3, pc = ht & 7;
#define AT_LOAD(it_) do { AT_DECODE(it_); \
        _Pragma("unroll") for (int i = 0; i < 8; ++i) { \
            if (n_ > 0 || i >= 4) { const int lpos_ = (n_ - 1) * 128 + 32 * i + rsub; const bf16* kp = KV + ((size_t)(b_ * 12 + h_) * 2048 + r_ * (2048 >> (2 * gi_)) + lpos_) * 128 + 8 * pc; \
                kv[i] = *(const v4u*)kp; vv[i] = *(const v4u*)(kp + 64); } \
            else { kv[i] = (v4u){0u, 0u, 0u, 0u}; vv[i] = (v4u){0u, 0u, 0u, 0u}; } } \
        _Pragma("unroll") for (int i = 0; i < 4; ++i) qv[i] = *(const v4u*)(Q + (row0_ + (size_t)(n_ * 128 + 32 * i + rsub) * dil_ + r_) * 768 + h_ * 64 + 8 * pc); } while (0)
    AT_LOAD(0);
    for (int it = 0; it < 6; ++it) {
        AT_DECODE(it);
        const int h = h_, dil = dil_, r = r_, n = n_; const size_t row0 = row0_;
        const size_t tokq = row0 + (size_t)(n * 128 + qi) * dil + r;
        __syncthreads();
        bf16x8 qr[4];
        {
#pragma unroll
            for (int i = 0; i < 4; ++i) *(LAS v4u*)(Kb + (32 * i + rsub) * 144 + pc * 16) = qv[i];
            __syncthreads();
#pragma unroll
            for (int d0 = 0; d0 < 4; ++d0) qr[d0] = *(const LAS bf16x8*)(Kb + qi * 144 + (16 * d0 + 8 * hi) * 2);
            __syncthreads();
        }
        {
#pragma unroll
            for (int i = 0; i < 8; ++i) { const int key = 32 * (i & 1) + rsub;
                *(LAS v4u*)(Kb + (i >> 1) * 8192 + pc * 1024 + ((key ^ (2 * pc)) * 16)) = kv[i];
                *(LAS v4u*)(Vb + (i >> 1) * 8192 + (pc >> 2) * 4096 + (key >> 4) * 1024 + (key & 15) * 64 + (pc & 3) * 16) = vv[i]; }
        }
        __syncthreads();
        if (it < 5) AT_LOAD(it + 1);
        const float cb = __builtin_amdgcn_exp2f(-8.f * (float)(h + 1) * (1.f / 12.f)) * (float)dil * LOG2E;
        const int smax = (n > 0) ? 128 : qi;
        float m = -INFINITY, lpart = 0.f;
        f32x16 o[2] = {{}, {}};
#pragma unroll 1
        for (int jj = 0; jj < 3; ++jj) {
            const int jt = a0 + jj;
            LAS const unsigned char* kb = Kb + jt * 8192 + hi * 1024;
            bf16x8 kf[8];
#pragma unroll
            for (int d0 = 0; d0 < 4; ++d0) { LAS const unsigned char* kp2 = kb + d0 * 2048 + ((r32 ^ (4 * d0 + 2 * hi)) * 16);
                kf[2 * d0] = *(const LAS bf16x8*)kp2; kf[2 * d0 + 1] = *(const LAS bf16x8*)(kp2 + 512); }
            f32x16 p0 = {}, p1 = {};
#pragma unroll
            for (int d0 = 0; d0 < 4; ++d0) { p0 = __builtin_amdgcn_mfma_f32_32x32x16_bf16(kf[2 * d0], qr[d0], p0, 0, 0, 0); p1 = __builtin_amdgcn_mfma_f32_32x32x16_bf16(kf[2 * d0 + 1], qr[d0], p1, 0, 0, 0); }
            const int sbase = qi + 128 - 64 * jt - 4 * hi;
            float tmax = -INFINITY;
#pragma unroll
            for (int rr = 0; rr < 16; ++rr) { const int st0 = sbase - ((rr & 3) + 8 * (rr >> 2)), st1 = st0 - 32;
                p0[rr] = ((unsigned)st0 <= (unsigned)smax) ? p0[rr] - cb * (float)st0 : -INFINITY;
                p1[rr] = ((unsigned)st1 <= (unsigned)smax) ? p1[rr] - cb * (float)st1 : -INFINITY;
                tmax = fmaxf(tmax, fmaxf(p0[rr], p1[rr])); }
            tmax = fmaxf(tmax, __shfl_xor(tmax, 32));
            const float mn = fmaxf(m, tmax), mu = (mn == -INFINITY) ? 0.f : mn;
            const float alpha = __builtin_amdgcn_exp2f(m - mu);
            float ps = 0.f;
#pragma unroll
            for (int rr = 0; rr < 16; ++rr) { p0[rr] = __builtin_amdgcn_exp2f(p0[rr] - mu); p1[rr] = __builtin_amdgcn_exp2f(p1[rr] - mu); ps += p0[rr] + p1[rr]; }
            lpart = lpart * alpha + ps; m = mn;
#pragma unroll
            for (int rr = 0; rr < 16; ++rr) { o[0][rr] *= alpha; o[1][rr] *= alpha; }
            bf16x8 paf[4];
#pragma unroll
            for (int ks = 0; ks < 4; ++ks) { const f32x16& pp = (ks >> 1) ? p1 : p0; const int bs = (ks & 1) * 8; v4u t4;
                t4.x = pg8::cvt_pk_bf16(pp[bs + 0], pp[bs + 1]); t4.y = pg8::cvt_pk_bf16(pp[bs + 2], pp[bs + 3]); t4.z = pg8::cvt_pk_bf16(pp[bs + 4], pp[bs + 5]); t4.w = pg8::cvt_pk_bf16(pp[bs + 6], pp[bs + 7]);
                paf[ks] = __builtin_bit_cast(bf16x8, t4); }
            LAS const unsigned char* vb = Vb + jt * 8192 + ((lane >> 4) & 1) * 32 + (lane & 3) * 8 + (4 * hi + ((lane & 15) >> 2)) * 64;
#pragma unroll
            for (int d0 = 0; d0 < 2; ++d0) { bf16x8 vfr[4];
#pragma unroll
                for (int ks = 0; ks < 4; ++ks) vfr[ks] = cat44(lds_tr(vb + d0 * 4096 + ks * 1024), lds_tr(vb + d0 * 4096 + ks * 1024 + 512));
#pragma unroll
                for (int ks = 0; ks < 4; ++ks) o[d0] = __builtin_amdgcn_mfma_f32_32x32x16_bf16(vfr[ks], paf[ks], o[d0], 0, 0, 0); }
        }
        const float lsum = lpart + __shfl_xor(lpart, 32);
        const float rl = 1.f / lsum;
        if (DRY) { asm volatile("" :: "v"(o[0][0] * rl), "v"(o[1][5] * rl), "v"(m), "v"(lsum)); continue; }
        bf16* op = Q + tokq * 768 + h * 64 + 8 * hi;
#pragma unroll
        for (int d0 = 0; d0 < 2; ++d0)
#pragma unroll
            for (int p = 0; p < 2; ++p) { const int qe = 2 * p, qo = 2 * p + 1;
                const unsigned ex = pg8::cvt_pk_bf16(o[d0][4 * qe] * rl, o[d0][4 * qe + 1] * rl), ey = pg8::cvt_pk_bf16(o[d0][4 * qe + 2] * rl, o[d0][4 * qe + 3] * rl);
                const unsigned ox = pg8::cvt_pk_bf16(o[d0][4 * qo] * rl, o[d0][4 * qo + 1] * rl), oy = pg8::cvt_pk_bf16(o[d0][4 * qo + 2] * rl, o[d0][4 * qo + 3] * rl);
                const auto sx = __builtin_amdgcn_permlane32_swap(ex, ox, false, false), sy = __builtin_amdgcn_permlane32_swap(ey, oy, false, false);
                const v4u val = {sx[0], sy[0], sx[1], sy[1]};
                *(v4u*)(op + 32 * d0 + 16 * p) = val; }
        if (hi == 0) LSE[tokq * 12 + h] = LN2 * (m + __builtin_amdgcn_logf(lsum));
    }
#undef AT_DECODE
#undef AT_LOAD
}
__device__ __forceinline__ void mixer_phase_a(Frame& F) {
    gla_prep<false>(F);
    __syncthreads();
    attn_units<false>(F);
}
__device__ __forceinline__ void mixer_phase_b(Frame& F) {
    gla_chain2<false>(F); }
__device__ __forceinline__ void combine_phase(Frame& F) {
    PHASE_LOCAL(F);
    const int gw = F.vcu * NWAVES + F.wave, lane = F.lane, hf = lane >> 5, l32 = lane & 31;
    const bf16* Qo = (const bf16*)(F.ws + WS_Q); const float* LSE = (const float*)(F.ws + WS_LSE); const float* SSQ = (const float*)(F.ws + WS_SSQ);
    bf16* GB = (bf16*)(F.ws + WS_GB); const bf16* GR = (const bf16*)(F.ws + WS_GR);
    const f32x4 gon0 = *(const f32x4*)(F.in[I_GONG] + 8 * l32), gon1 = *(const f32x4*)(F.in[I_GONG] + 8 * l32 + 4);
    for (int i0 = 0; i0 < 16; i0 += 4) {
        float l0[2], l1[2], l2[2]; v2u sq[2]; v4u ga[2], gb[2], gc[2], ov[2][4], gv[2][4];
#pragma unroll
        for (int q = 0; q < 2; ++q) { const size_t tok = (size_t)gw * 16 + i0 + 2 * q + hf; const int j = l32 >> 3;
            l0[q] = LSE[tok * 12 + j]; l1[q] = LSE[tok * 12 + 4 + j]; l2[q] = LSE[tok * 12 + 8 + j];
            const bf16* og_ = Qo + tok * 768 + 8 * l32;
            ga[q] = *(const v4u*)og_; gb[q] = *(const v4u*)(og_ + 256); gc[q] = *(const v4u*)(og_ + 512);
            sq[q] = *(const v2u*)(SSQ + tok * 64 + 2 * l32);
#pragma unroll
            for (int hh = 0; hh < 4; ++hh) { ov[q][hh] = *(const v4u*)(GB + tok * 2048 + 1024 + hh * 256 + 8 * l32); gv[q][hh] = *(const v4u*)(GR + tok * 1024 + hh * 256 + 8 * l32); } }
#pragma unroll
        for (int q = 0; q < 2; ++q) { const size_t tok = (size_t)gw * 16 + i0 + 2 * q + hf;
            {
                const float mm = fmaxf(l0[q], fmaxf(l1[q], l2[q]));
                float w0 = __expf(l0[q] - mm), w1 = __expf(l1[q] - mm), w2 = __expf(l2[q] - mm); const float inv = 1.f / (w0 + w1 + w2); w0 *= inv; w1 *= inv; w2 *= inv;
                const unsigned av[4] = {ga[q].x, ga[q].y, ga[q].z, ga[q].w}, bv[4] = {gb[q].x, gb[q].y, gb[q].z, gb[q].w}, cv[4] = {gc[q].x, gc[q].y, gc[q].z, gc[q].w};
                unsigned o[4];
#pragma unroll
                for (int e = 0; e < 4; ++e) o[e] = pk2(w0 * bflo(av[e]) + w1 * bflo(bv[e]) + w2 * bflo(cv[e]), w0 * bfhi(av[e]) + w1 * bfhi(bv[e]) + w2 * bfhi(cv[e]));
                *(v4u*)(GB + tok * 2048 + 768 + 8 * l32) = (v4u){o[0], o[1], o[2], o[3]};
            }
            {
                float s = __uint_as_float(sq[q].x) + __uint_as_float(sq[q].y);
                s += __shfl_xor(s, 1); s += __shfl_xor(s, 2); s += __shfl_xor(s, 4);
#pragma unroll
                for (int hh = 0; hh < 4; ++hh) {
                    const float rstd = 1.f / sqrtf(__shfl(s, (lane & 32) | (8 * hh)) * (1.f / 256.f) + EPS);
                    const unsigned xo[4] = {ov[q][hh].x, ov[q][hh].y, ov[q][hh].z, ov[q][hh].w}, xg[4] = {gv[q][hh].x, gv[q][hh].y, gv[q][hh].z, gv[q][hh].w};
                    unsigned o[4];
#pragma unroll
                    for (int e = 0; e < 4; ++e) { const float g0 = bflo(xg[e]), g1 = bfhi(xg[e]); const float n0 = (e < 2) ? gon0[2 * e] : gon1[2 * e - 4], n1 = (e < 2) ? gon0[2 * e + 1] : gon1[2 * e - 3];
                        o[e] = pk2(bflo(xo[e]) * rstd * n0 * (g0 / (1.f + __expf(-g0))), bfhi(xo[e]) * rstd * n1 * (g1 / (1.f + __expf(-g1)))); }
                    *(v4u*)(GB + tok * 2048 + 1024 + hh * 256 + 8 * l32) = (v4u){o[0], o[1], o[2], o[3]};
                }
            }
        }
    }
}
#ifndef LAST_PHASE
#define LAST_PHASE 99
#endif
constexpr int LDS_BYTES = 147456;
__global__ void __launch_bounds__(NTHREADS, 2) mega_fwd(Args args) {
    extern __shared__ __attribute__((aligned(16))) unsigned char lds[];
    __builtin_assume(__builtin_amdgcn_workitem_id_y() == 0); __builtin_assume(__builtin_amdgcn_workitem_id_z() == 0);
#if USE_CG_SYNC
    cg::grid_group grid = cg::this_grid();
#endif
    Frame F;
    F.lds = (LAS unsigned char*)lds;
    F.wave = __builtin_amdgcn_readfirstlane((int)threadIdx.x >> 6); F.tid = 0; F.lane = 0;
    F.G = gridDim.x; { const int bx = blockIdx.x; F.vcu = (F.G % 8 == 0) ? (bx % 8) * (F.G / 8) + bx / 8 : bx; }
    F.in = args.in; F.out = args.out; F.ws = args.ws;
    unsigned char* ws = args.ws;
    const float* mod = (const float*)(ws + WS_MOD);
    bf16* U = (bf16*)(ws + WS_U);
    bf16* H1 = (bf16*)args.out;
    bf16* H2 = (bf16*)(ws + WS_GR);
    const int lo = args.ph_lo, hi = args.ph_hi;
#define IN(k) (lo <= (k) && (k) < hi && (k) <= LAST_PHASE)
    volatile LAS unsigned* MISC = (volatile LAS unsigned*)(F.lds + 147392);
    unsigned* barw = (unsigned*)(ws + WS_CTL);
    XcdBarrier bar; bar.bar = barw; bar.x = 0; bar.st = MISC;
    const bool multi = (hi - lo) > 1;
    if (multi) {
#if USE_CG_SYNC
        if (blockIdx.x == 0) for (int i = threadIdx.x; i < XCD_BAR_WORDS; i += NTHREADS) barw[i] = 0u;
#endif
        if (threadIdx.x < 2) MISC[threadIdx.x] = 0u;
    }
#define BARRIER_NOW() do { PHASE_LOCAL(F); xcd_barrier(bar, F.tid == 0); } while (0)
#define SEAM(k) do { if (IN(k) && IN((k) + 1)) { PHASE_LOCAL(F); xcd_barrier(bar, F.tid == 0); } } while (0)
#if !USE_CG_SYNC
    if (multi) { __syncthreads(); PHASE_LOCAL(F); bar = xcd_barrier_post(barw, MISC, F.tid == 0); }
#endif
    if (IN(0)) { p0_prologue(F); p0_mod(F); }
#if USE_CG_SYNC
    if (IN(0) && IN(1)) { grid.sync(); PHASE_LOCAL(F); bar = xcd_barrier_post(barw, MISC, F.tid == 0); }
#else
    SEAM(0);
#endif
    if (IN(1)) norm_phase<false>(F, args.in[I_X], args.in[I_GFFN1], 0, U);
    SEAM(1);
    if (IN(2)) { pg8::Gemm g{U, (const bf16*)(ws + WS_W13_1), T, 2 * DFF, D, D, D}; pg8::StaticOrder S; S.init(T, 2 * DFF, F.G, (int)blockIdx.x);
        pg8::EpiSwiGLU E{(bf16*)(ws + WS_HACT), DFF}; pg8::gemm_phase(F.lds, g, S, E, F.wave); }
    SEAM(2);
    if (IN(3)) { pg8::Gemm g{(const bf16*)(ws + WS_HACT), (const bf16*)(ws + WS_W2_1), T, D, DFF, DFF, DFF, 1}; pg8::StaticOrder S; S.init(T, D, F.G, (int)blockIdx.x);
        pg8::EpiResidual<false, true> E{args.in[I_X], H1, mod + 2 * D, 0.5f}; pg8::gemm_phase(F.lds, g, S, E, F.wave); }
    SEAM(3);
    if (IN(4)) norm_phase<true>(F, H1, args.in[I_GMIX], 3, U);
    SEAM(4);
    if (IN(5)) { pg8::Gemm g{U, (const bf16*)(ws + WS_WIN), T, N_PROJ1, D, D, D}; pg8::StaticOrder S; S.init(T, N_PROJ1, F.G, (int)blockIdx.x);
        pg8::EpiProj E{(bf16*)(ws + WS_Q), (bf16*)(ws + WS_KV), (bf16*)(ws + WS_GB), (bf16*)(ws + WS_GR), (bf16*)(ws + WS_GD), args.in[I_QNG], args.in[I_KNG]}; pg8::gemm_phase(F.lds, g, S, E, F.wave); }
    SEAM(5);
    if (IN(6)) { mixer_phase_a(F); if (multi) BARRIER_NOW(); else {   } if (multi) mixer_phase_b(F); }
    SEAM(6);
    bf16* SA = (bf16*)args.out + (size_t)T * D; bf16* SGG = (bf16*)(ws + WS_KV);
    if (IN(7)) { if (!multi) mixer_phase_b(F);
        const int cls = ((int)blockIdx.x >> 5) & 1;
#pragma unroll 1
        for (int step = 0; step < 2; ++step) {
            if ((step ^ cls) == 0) combine_phase(F);
            else { pg8::Gemm g{U, (const bf16*)(ws + WS_WIN) + (size_t)N_PROJ1 * D, T, N_GATES, D, D, D}; pg8::StaticOrder S; S.init(T, N_GATES, F.G, (int)blockIdx.x);
                pg8::EpiGates E{SA, SGG}; pg8::gemm_phase(F.lds, g, S, E, F.wave); }
            __syncthreads(); }
    }
    SEAM(7);
    if (IN(9)) { pg8::Gemm g{(const bf16*)(ws + WS_GB) + 768, (const bf16*)(ws + WS_WB), T, D, 1280, 2048, 1280}; pg8::StaticOrder S; S.init(T, D, F.G, (int)blockIdx.x);
        pg8::EpiBranch E{SA, SGG, U};
        pg8::gemm_phase(F.lds, g, S, E, F.wave); }
    SEAM(9);
    if (IN(10)) { pg8::Gemm g{U, (const bf16*)(ws + WS_WOUT), T, D, D, D, D};
        pg8::StaticOrder S; S.init(T, D, F.G, (int)blockIdx.x);
        pg8::EpiResidual<true, true> E{H1, H2, mod + 5 * D, 1.0f}; pg8::gemm_phase(F.lds, g, S, E, F.wave); }
    SEAM(10);
    if (IN(11)) norm_phase<true>(F, H2, args.in[I_GFFN2], 6, U);
    SEAM(11);
    if (IN(12)) { pg8::Gemm g{U, (const bf16*)(ws + WS_W13_2), T, 2 * DFF, D, D, D}; pg8::StaticOrder S; S.init(T, 2 * DFF, F.G, (int)blockIdx.x);
        pg8::EpiSwiGLU E{(bf16*)(ws + WS_HACT), DFF}; pg8::gemm_phase(F.lds, g, S, E, F.wave); }
    SEAM(12);
    if (IN(13)) { pg8::Gemm g{(const bf16*)(ws + WS_HACT), (const bf16*)(ws + WS_W2_2), T, D, DFF, DFF, DFF, 1}; pg8::StaticOrder S; S.init(T, D, F.G, (int)blockIdx.x);
        pg8::EpiResidual<true, false> E{H2, args.out, mod + 8 * D, 0.5f}; pg8::gemm_phase(F.lds, g, S, E, F.wave); }
#undef IN
#undef SEAM
}

#ifndef N_LAUNCHES
#define N_LAUNCHES 1
#endif
constexpr int N_PHASES = 14;
extern "C" void kernel_launch(void* const* d_in, const int* in_sizes, int n_in, void* d_out, int out_size, void* d_ws, size_t ws_size, hipStream_t stream) {
    static int grid = 0;
    if (grid == 0) {
        int dev = 0, cus = 0, per_cu = 0;
        if (n_in != 22 || out_size != T * D || ws_size < WS_END) { fprintf(stderr, "kernel_launch: unexpected shapes (n_in %d out %d ws %zu)\n", n_in, out_size, ws_size); grid = -1; return; }
        (void)hipGetDevice(&dev);
        (void)hipDeviceGetAttribute(&cus, hipDeviceAttributeMultiprocessorCount, dev);
        (void)hipFuncSetAttribute((const void*)mega_fwd, hipFuncAttributeMaxDynamicSharedMemorySize, LDS_BYTES);
        (void)hipOccupancyMaxActiveBlocksPerMultiprocessor(&per_cu, (const void*)mega_fwd, NTHREADS, LDS_BYTES);
        if (per_cu < 1) per_cu = 1;
        grid = cus * per_cu;
        if (grid > 256) grid = 256;
        if (grid != 256) fprintf(stderr, "kernel_launch: grid %d != 256\n", grid);
        (void)hipGetLastError();
    }
    if (grid < 0) return;
    Args a{};
    for (int i = 0; i < 22; ++i) a.in[i] = (const float*)d_in[i];
    a.out = (float*)d_out; a.ws = (unsigned char*)d_ws;
    if (N_LAUNCHES == 1) {
        a.ph_lo = 0; a.ph_hi = N_PHASES;
        void* kargs[] = {&a};
#if !USE_CG_SYNC
        (void)hipMemsetAsync((char*)d_ws + WS_CTL, 0, XCD_BAR_WORDS * 4, stream);
#endif
        hipError_t e = hipLaunchCooperativeKernel((void*)mega_fwd, dim3(grid), dim3(NTHREADS), kargs, LDS_BYTES, stream);
        if (e != hipSuccess) fprintf(stderr, "cooperative launch failed: %s (grid %d)\n", hipGetErrorString(e), grid);
    } else {
        for (int p = 0; p < N_PHASES; ++p) { a.ph_lo = p; a.ph_hi = p + 1; hipLaunchKernelGGL(mega_fwd, dim3(grid), dim3(NTHREADS), LDS_BYTES, stream, a); }
    }
}
```

```cpp
#include <hip/hip_runtime.h>
#include <type_traits>
#ifndef USE_CG_SYNC
#define USE_CG_SYNC 0
#endif
#include <hip/hip_cooperative_groups.h>
#include <cstdio>
#include <cstdint>
namespace cg = cooperative_groups;
namespace pg8 {
#define PG8_LAS __attribute__((address_space(3)))
typedef unsigned short bf16_t;
typedef short bf16x8 __attribute__((ext_vector_type(8)));
typedef float f32x4 __attribute__((ext_vector_type(4)));
typedef float f32x2 __attribute__((ext_vector_type(2)));
typedef unsigned u32x4 __attribute__((ext_vector_type(4)));
typedef unsigned u32x2 __attribute__((ext_vector_type(2)));
constexpr int BM = 256, BK = 64, HALF = 128, HTB = HALF * BK * 2, STAGE_BYTES = 8 * HTB, NXCD = 8, WGM = 4;

__host__ __device__ __forceinline__ int lds_byte(int r, int c) { const int st = (r >> 4) * 2 + (c >> 5), rr = r & 15, cc = c & 31, ob = rr * 64 + cc * 2; return st * 1024 + (ob ^ (((ob >> 9) & 1) << 5)); }
__host__ __device__ __forceinline__ void stage_rc(int b, int& R, int& C) { const int st = b / 1024, sb = b % 1024, swz = sb ^ (((sb >> 9) & 1) << 5); R = (st >> 1) * 16 + swz / 64; C = (st & 1) * 32 + (swz % 64) / 2; }
__host__ __device__ __forceinline__ int perm32(int rho) { const int n = rho >> 4, i = rho & 15; return 8 * (i >> 2) + 4 * n + (i & 3); }

struct Unit { int pm, pn; };
struct Gemm { const bf16_t* A; const bf16_t* Bt; int M, N, K, lda, ldb; int ablk; };

struct StaticOrder {
    int nM, nN, nwg, G, c;
    __device__ void init(int M, int N, int G_, int c_) { nM = M / BM; nN = N / BM; nwg = nM * nN; G = G_; c = c_; }
    __device__ bool next(int i, Unit& u) const {
        const long L = (long)i * G + c; if (L >= nwg) return false;
        int wgid = (int)L; { const int q = nwg / NXCD, r = nwg % NXCD, xcd = wgid % NXCD, off = wgid / NXCD; wgid = (xcd < r ? xcd * (q + 1) : r * (q + 1) + (xcd - r) * q) + off; }
        const int nig = WGM * nN, gid = wgid / nig, fm = gid * WGM, gsz = (nM - fm) < WGM ? (nM - fm) : WGM;
        u.pm = fm + ((wgid % nig) % gsz); u.pn = (wgid % nig) / gsz; return true;
    }
};

typedef __bf16 bf16x2_t __attribute__((ext_vector_type(2)));
__device__ __forceinline__ unsigned cvt_pk_bf16(float lo, float hi) { f32x2 v = {lo, hi}; bf16x2_t b = __builtin_convertvector(v, bf16x2_t); return __builtin_bit_cast(unsigned, b); }
__device__ __forceinline__ float bf_lo(unsigned w) { return __uint_as_float(w << 16); }
__device__ __forceinline__ float bf_hi(unsigned w) { return __uint_as_float(w & 0xffff0000u); }
__device__ __forceinline__ float fast_sigmoid(float x) { return __builtin_amdgcn_rcpf(1.0f + __builtin_amdgcn_exp2f(-1.4426950408889634f * x)); }

typedef f32x4 Acc[2][2][4][2];

struct EpiSwiGLU {
    static constexpr bool PERM = true; static constexpr int MIDK_T = 0, CMAP = 0;
    bf16_t* O; int ldc;
    __device__ __forceinline__ void mid(Acc&, const Unit&, int, int, int, int, int) const {}
    __device__ __forceinline__ void operator()(const Acc& acc, const Unit& u, int wr, int wc, int fr, int fq) const {
        const int kt = u.pn * 2 + (wc >> 1), c0 = (wc & 1) * 32 + 8 * fq, r0 = wr * 64 + fr;
        bf16_t* tile = O + ((size_t)(u.pm * (ldc >> 6) + kt) * BM + r0) * BK + c0;
#pragma unroll
        for (int ai = 0; ai < 2; ++ai)
#pragma unroll
            for (int m = 0; m < 4; ++m) {
                bf16_t* rowp = tile + (ai * HALF + m * 16) * BK;
                float r[8];
#pragma unroll
                for (int n = 0; n < 2; ++n)
#pragma unroll
                    for (int j = 0; j < 4; ++j) { const float g = acc[ai][0][m][n][j], up = acc[ai][1][m][n][j]; r[n * 4 + j] = g * fast_sigmoid(g) * up; }
                u32x4 w; w.x = cvt_pk_bf16(r[0], r[1]); w.y = cvt_pk_bf16(r[2], r[3]); w.z = cvt_pk_bf16(r[4], r[5]); w.w = cvt_pk_bf16(r[6], r[7]);
                __builtin_nontemporal_store(w, (u32x4*)rowp);
            }
    }
};
template <bool BASE_BF16, bool OUT_BF16> struct EpiResidual {
    static constexpr bool PERM = true; static constexpr int MIDK_T = 0, CMAP = 0;
    const void* base; void* out; const float* gt; float coef;
    __device__ __forceinline__ void mid(Acc&, const Unit&, int, int, int, int, int) const {}
    __device__ __forceinline__ void operator()(const Acc& acc, const Unit& u, int wr, int wc, int fr, int fq) const {
        const int row0 = u.pm * BM + wr * 64 + fr, col0 = u.pn * BM + wc * 32 + 8 * fq;
        const float* g = gt + (size_t)((u.pm * BM) >> 11) * 9216 + col0;
        f32x4 gv[2][2];
#pragma unroll
        for (int bj = 0; bj < 2; ++bj)
#pragma unroll
            for (int n = 0; n < 2; ++n) gv[bj][n] = (*(const f32x4*)(g + bj * HALF + 4 * n) + 1.0f) * coef;
#pragma unroll
        for (int ai = 0; ai < 2; ++ai)
#pragma unroll
            for (int m = 0; m < 4; ++m) { const size_t off = (size_t)(row0 + ai * HALF + m * 16) * 1024 + col0;
#pragma unroll
                for (int bj = 0; bj < 2; ++bj) {
                    f32x4 b0, b1;
                    if (BASE_BF16) { const u32x4 t = __builtin_nontemporal_load((const u32x4*)((const bf16_t*)base + off + bj * HALF));
                        b0 = (f32x4){bf_lo(t.x), bf_hi(t.x), bf_lo(t.y), bf_hi(t.y)}; b1 = (f32x4){bf_lo(t.z), bf_hi(t.z), bf_lo(t.w), bf_hi(t.w)}; }
                    else { b0 = __builtin_nontemporal_load((const f32x4*)((const float*)base + off + bj * HALF)); b1 = __builtin_nontemporal_load((const f32x4*)((const float*)base + off + bj * HALF + 4)); }
                    const f32x4 o0 = b0 + gv[bj][0] * acc[ai][bj][m][0], o1 = b1 + gv[bj][1] * acc[ai][bj][m][1];
                    if (OUT_BF16) { u32x4 w; w.x = cvt_pk_bf16(o0[0], o0[1]); w.y = cvt_pk_bf16(o0[2], o0[3]); w.z = cvt_pk_bf16(o1[0], o1[1]); w.w = cvt_pk_bf16(o1[2], o1[3]);
                        *(u32x4*)((bf16_t*)out + off + bj * HALF) = w; }
                    else { __builtin_nontemporal_store(o0, (f32x4*)((float*)out + off + bj * HALF)); __builtin_nontemporal_store(o1, (f32x4*)((float*)out + off + bj * HALF + 4)); } }
                if (m == 3) asm volatile("" ::: "memory"); }
    }
};
__device__ __forceinline__ u32x4 xchg8(u32x4 v) { u32x4 r;
    r.x = (unsigned)__builtin_amdgcn_update_dpp(0, (int)v.x, 0x128, 0xf, 0xf, false); r.y = (unsigned)__builtin_amdgcn_update_dpp(0, (int)v.y, 0x128, 0xf, 0xf, false);
    r.z = (unsigned)__builtin_amdgcn_update_dpp(0, (int)v.z, 0x128, 0xf, 0xf, false); r.w = (unsigned)__builtin_amdgcn_update_dpp(0, (int)v.w, 0x128, 0xf, 0xf, false); return r; }
struct EpiProj {
    static constexpr bool PERM = true; static constexpr int MIDK_T = 0, CMAP = 1;
    bf16_t *Q, *KV, *GB, *GR, *GD; const float* qg; const float* kg; const float* gon;
    __device__ __forceinline__ void mid(Acc&, const Unit&, int, int, int, int, int) const {}
    __device__ __forceinline__ void operator()(const Acc& acc, const Unit& u, int wr, int wc, int fr, int fq) const {
        bf16_t* base; int ldc, colt;
        const bool kvt = u.pn >= 3 && u.pn < 9;
        if (u.pn < 9) { base = Q; ldc = 768; colt = u.pn * 256; }
        else if (u.pn < 17) { base = GB; ldc = 2048; colt = (u.pn - 9) * 256; }
        else if (u.pn < 21) { base = GR; ldc = 1024; colt = (u.pn - 17) * 256; }
        else { base = GD; ldc = 256; colt = 0; }
        const bool lo = fr < 8;
        const int rowb = u.pm * BM + wr * 64 + (fr & 7), col = colt + wc * 64 + (lo ? 0 : 32) + 8 * fq;
        const bool nrm = u.pn < 3 || (u.pn < 9 && !(wc & 1));
        const bool gat = u.pn >= 17 && u.pn < 21;
        f32x4 gn[2][2];
        if (gat) {
#pragma unroll
            for (int bj = 0; bj < 2; ++bj)
#pragma unroll
                for (int n = 0; n < 2; ++n) gn[bj][n] = *(const f32x4*)(gon + wc * 64 + 32 * bj + 8 * fq + 4 * n); }
        if (nrm) { const float* gp = (u.pn < 3 ? qg : kg) + 8 * fq; const float sc = (u.pn < 3) ? 0.125f * 1.4426950408889634f : 1.0f;
#pragma unroll
            for (int bj = 0; bj < 2; ++bj)
#pragma unroll
                for (int n = 0; n < 2; ++n) gn[bj][n] = *(const f32x4*)(gp + 32 * bj + 4 * n) * sc; }
#pragma unroll
        for (int ai = 0; ai < 2; ++ai)
#pragma unroll
            for (int m = 0; m < 4; ++m) {
                f32x4 v[2][2];
#pragma unroll
                for (int bj = 0; bj < 2; ++bj) { v[bj][0] = acc[ai][bj][m][0]; v[bj][1] = acc[ai][bj][m][1]; }
                if (nrm) { float ss = 0.f;
#pragma unroll
                    for (int bj = 0; bj < 2; ++bj)
#pragma unroll
                        for (int n = 0; n < 2; ++n) ss += (v[bj][n][0] * v[bj][n][0] + v[bj][n][1] * v[bj][n][1]) + (v[bj][n][2] * v[bj][n][2] + v[bj][n][3] * v[bj][n][3]);
                    ss += __shfl_xor(ss, 16); ss += __shfl_xor(ss, 32);
                    const float rstd = 1.0f / sqrtf(ss * (1.0f / 64.0f) + 1e-6f);
#pragma unroll
                    for (int bj = 0; bj < 2; ++bj)
#pragma unroll
                        for (int n = 0; n < 2; ++n) v[bj][n] = v[bj][n] * rstd * gn[bj][n]; }
                if (gat) {
#pragma unroll
                    for (int bj = 0; bj < 2; ++bj)
#pragma unroll
                        for (int n = 0; n < 2; ++n)
#pragma unroll
                            for (int j = 0; j < 4; ++j) v[bj][n][j] = v[bj][n][j] * fast_sigmoid(v[bj][n][j]) * gn[bj][n][j]; }
                u32x4 w[2];
#pragma unroll
                for (int bj = 0; bj < 2; ++bj) { w[bj].x = cvt_pk_bf16(v[bj][0][0], v[bj][0][1]); w[bj].y = cvt_pk_bf16(v[bj][0][2], v[bj][0][3]); w[bj].z = cvt_pk_bf16(v[bj][1][0], v[bj][1][1]); w[bj].w = cvt_pk_bf16(v[bj][1][2], v[bj][1][3]); }
                u32x4 snd; snd.x = lo ? w[1].x : w[0].x; snd.y = lo ? w[1].y : w[0].y; snd.z = lo ? w[1].z : w[0].z; snd.w = lo ? w[1].w : w[0].w;
                const u32x4 rcv = xchg8(snd);
                u32x4 pa, pb; pa.x = lo ? w[0].x : rcv.x; pa.y = lo ? w[0].y : rcv.y; pa.z = lo ? w[0].z : rcv.z; pa.w = lo ? w[0].w : rcv.w;
                pb.x = lo ? rcv.x : w[1].x; pb.y = lo ? rcv.y : w[1].y; pb.z = lo ? rcv.z : w[1].z; pb.w = lo ? rcv.w : w[1].w;
                const int R = rowb + ai * HALF + m * 16;
                if (kvt) { const int hh = (u.pn - 3) * 2 + (wc >> 1), ld2 = 2 * (hh >> 2), dm = (1 << ld2) - 1, t0 = R & 2047, t1 = t0 + 8;
                    bf16_t* hb = KV + ((size_t)((R >> 11) * 12 + hh) * 2048) * 128 + (wc & 1) * 64 + (lo ? 0 : 32) + 8 * fq;
                    __builtin_nontemporal_store(pa, (u32x4*)(hb + (size_t)(((t0 & dm) << (11 - ld2)) + (t0 >> ld2)) * 128)); __builtin_nontemporal_store(pb, (u32x4*)(hb + (size_t)(((t1 & dm) << (11 - ld2)) + (t1 >> ld2)) * 128)); }
                else { bf16_t* rowp = base + (size_t)R * ldc + col;
                    __builtin_nontemporal_store(pa, (u32x4*)rowp); __builtin_nontemporal_store(pb, (u32x4*)(rowp + (size_t)8 * ldc)); } }
    }
};
template <int ACT> struct EpiBf16 {
    static constexpr bool PERM = true; static constexpr int MIDK_T = 0, CMAP = 0;
    bf16_t* O; int ldc;
    __device__ __forceinline__ void mid(Acc&, const Unit&, int, int, int, int, int) const {}
    __device__ __forceinline__ void operator()(const Acc& acc, const Unit& u, int wr, int wc, int fr, int fq) const {
        const int row0 = u.pm * BM + wr * 64 + fr, col0 = u.pn * BM + wc * 32 + 8 * fq;
#pragma unroll
        for (int ai = 0; ai < 2; ++ai)
#pragma unroll
            for (int m = 0; m < 4; ++m) { bf16_t* rowp = O + (size_t)(row0 + ai * HALF + m * 16) * ldc + col0;
#pragma unroll
                for (int bj = 0; bj < 2; ++bj) { f32x4 v0 = acc[ai][bj][m][0], v1 = acc[ai][bj][m][1];
                    if (ACT == 1) {
#pragma unroll
                        for (int j = 0; j < 4; ++j) { v0[j] = fast_sigmoid(v0[j]); v1[j] = fast_sigmoid(v1[j]); } }
                    u32x4 w; w.x = cvt_pk_bf16(v0[0], v0[1]); w.y = cvt_pk_bf16(v0[2], v0[3]); w.z = cvt_pk_bf16(v1[0], v1[1]); w.w = cvt_pk_bf16(v1[2], v1[3]);
                    *(u32x4*)(rowp + bj * HALF) = w; } }
    }
};
struct EpiGates {
    static constexpr bool PERM = true; static constexpr int MIDK_T = 0, CMAP = 0;
    bf16_t* RA; bf16_t* SGG;
    __device__ __forceinline__ void mid(Acc&, const Unit&, int, int, int, int, int) const {}
    __device__ __forceinline__ void operator()(const Acc& acc, const Unit& u, int wr, int wc, int fr, int fq) const {
        const int row0 = u.pm * BM + wr * 64 + fr, col0 = u.pn * HALF + wc * 32 + 8 * fq;
#pragma unroll
        for (int ai = 0; ai < 2; ++ai)
#pragma unroll
            for (int m = 0; m < 4; ++m) { const size_t ro = (size_t)(row0 + ai * HALF + m * 16) * 1024 + col0;
                float ra[8], sg[8];
#pragma unroll
                for (int n = 0; n < 2; ++n)
#pragma unroll
                    for (int j = 0; j < 4; ++j) { const float a = acc[ai][0][m][n][j], g = acc[ai][1][m][n][j];
                        const float ea = __builtin_amdgcn_exp2f(-1.4426950408889634f * a), eg = __builtin_amdgcn_exp2f(fminf(-1.4426950408889634f * g, 60.f));
                        ra[n * 4 + j] = __builtin_amdgcn_rcpf(1.0f + ea) * (1.0f + eg); sg[n * 4 + j] = __builtin_amdgcn_rcpf(1.0f + eg); }
                u32x4 w; w.x = cvt_pk_bf16(ra[0], ra[1]); w.y = cvt_pk_bf16(ra[2], ra[3]); w.z = cvt_pk_bf16(ra[4], ra[5]); w.w = cvt_pk_bf16(ra[6], ra[7]);
                *(u32x4*)(RA + ro) = w;
                w.x = cvt_pk_bf16(sg[0], sg[1]); w.y = cvt_pk_bf16(sg[2], sg[3]); w.z = cvt_pk_bf16(sg[4], sg[5]); w.w = cvt_pk_bf16(sg[6], sg[7]);
                *(u32x4*)(SGG + ro) = w; }
    }
};
struct EpiBranch {
    static constexpr bool PERM = true; static constexpr int MIDK_T = 4, CMAP = 0;
    const float* RQ; PG8_LAS float* ST;
    const bf16_t* SA; const bf16_t* SGG; bf16_t* O;
    __device__ __forceinline__ void mid(Acc& acc, const Unit& u, int wr, int wc, int fr, int fq, const int which) const {
        int row0 = u.pm * BM + wr * 64 + fr, col0 = u.pn * BM + wc * 32 + 8 * fq;
        asm volatile("" : "+v"(row0), "+v"(col0));
        const int wv = wr * 4 + wc;
        if (which == 1) {
            {   const int ln = (row0 & 15) + 16 * ((col0 >> 3) & 3);
#pragma unroll
                for (int k = 0; k < 2; ++k) { const int lr = ln + 64 * k;
                    *(PG8_LAS f32x4*)(ST + (wv * 128 + lr) * 4) = *(const f32x4*)(RQ + (size_t)(u.pm * BM + wr * 64 + (lr & 63) + (lr >> 6) * HALF) * 8); } }
            asm volatile("" ::: "memory");
#pragma unroll
            for (int ai = 0; ai < 2; ++ai)
#pragma unroll
                for (int m = 0; m < 4; ++m) { const size_t r = (size_t)(row0 + ai * HALF + m * 16);
#pragma unroll
                    for (int bj = 0; bj < 2; ++bj) { const u32x4 a = __builtin_nontemporal_load((const u32x4*)(SA + r * 1024 + col0 + bj * HALF));
                        f32x4 r0, r1;
                        r0[0] = bf_lo(a.x); r0[1] = bf_hi(a.x); r0[2] = bf_lo(a.y); r0[3] = bf_hi(a.y); r1[0] = bf_lo(a.z); r1[1] = bf_hi(a.z); r1[2] = bf_lo(a.w); r1[3] = bf_hi(a.w);
                        acc[ai][bj][m][0] *= r0; acc[ai][bj][m][1] *= r1; } }
            asm volatile("" ::: "memory"); }
        const int lb = (wv * 128 + (row0 & 15)) * 4 + (which - 1);
#pragma unroll
        for (int ai = 0; ai < 2; ++ai)
#pragma unroll
            for (int m = 0; m < 4; ++m) { const float sc = ST[lb + (16 * m + 64 * ai) * 4];
#pragma unroll
                for (int bj = 0; bj < 2; ++bj) { acc[ai][bj][m][0] *= sc; acc[ai][bj][m][1] *= sc; } }
    }
    __device__ __forceinline__ void operator()(const Acc& acc, const Unit& u, int wr, int wc, int fr, int fq) const {
        const int row0 = u.pm * BM + wr * 64 + fr, col0 = u.pn * BM + wc * 32 + 8 * fq;
#pragma unroll
        for (int ai = 0; ai < 2; ++ai)
#pragma unroll
            for (int m = 0; m < 4; ++m) { const size_t r = (size_t)(row0 + ai * HALF + m * 16); const float q4 = RQ[r * 8 + 4];
#pragma unroll
                for (int bj = 0; bj < 2; ++bj) { const u32x4 g = __builtin_nontemporal_load((const u32x4*)(SGG + r * 1024 + col0 + bj * HALF));
                    f32x4 v0 = acc[ai][bj][m][0] * q4, v1 = acc[ai][bj][m][1] * q4;
                    u32x4 w; w.x = cvt_pk_bf16(v0[0] * bf_lo(g.x), v0[1] * bf_hi(g.x)); w.y = cvt_pk_bf16(v0[2] * bf_lo(g.y), v0[3] * bf_hi(g.y));
                    w.z = cvt_pk_bf16(v1[0] * bf_lo(g.z), v1[1] * bf_hi(g.z)); w.w = cvt_pk_bf16(v1[2] * bf_lo(g.w), v1[3] * bf_hi(g.w));
                    *(u32x4*)(O + r * 1024 + col0 + bj * HALF) = w; }
                if (m == 3) asm volatile("" ::: "memory"); }
    }
};


template <class Epi, class Sched>
__device__ __forceinline__ void gemm_phase(PG8_LAS unsigned char* lds, const Gemm g, const Sched& S, const Epi& E, const int wave_id  ) {
    int lane_ = __builtin_amdgcn_mbcnt_hi(~0u, __builtin_amdgcn_mbcnt_lo(~0u, 0u)); asm volatile("" : "+v"(lane_));
    const int wid = wave_id, lane = lane_, tid = wid * 64 + lane, wr = wid >> 2, wc = wid & 3, fr = lane & 15, fq = lane >> 4;
    const int K = g.K, nt = K / BK, lda = g.lda, ldb = g.ldb;
    unsigned voffA[2], voffB[2];
#pragma unroll
    for (int i = 0; i < 2; ++i) { int R, C; stage_rc(tid * 16 + i * 8192, R, C); const int Rb = Epi::PERM ? (Epi::CMAP ? (64 * (R >> 5) + perm32(R & 31)) : ((R & ~31) + perm32(R & 31))) : R;
        voffA[i] = (unsigned)(R * (g.ablk ? BK : lda) + C) * 2u; voffB[i] = (unsigned)(Rb * ldb + C) * 2u; }
    const size_t kstep = (size_t)(BK * 2), kstepA = g.ablk ? (size_t)(BM * BK * 2) : kstep;
    const size_t hstepA = g.ablk ? (size_t)(HALF * BK * 2) : (size_t)HALF * lda * 2, hstepB = (size_t)(Epi::CMAP ? 32 : HALF) * ldb * 2;
    const size_t tstepA = g.ablk ? (size_t)nt * kstepA : 2 * hstepA, tstepB = (size_t)BM * ldb * 2;
    const unsigned ldsw = (unsigned)wid * 1024u;
    const int aoff = lds_byte(wr * 64 + fr, fq * 8), boff = lds_byte(wc * 32 + fr, fq * 8);
#define PG8_SA(b, h) (((b) * 2 + (h)) * HTB)
#define PG8_SB(b, h) ((4 + (b) * 2 + (h)) * HTB)
#define PG8_STAGE(bufoff, gbase, voff) do { _Pragma("unroll") for (int _i = 0; _i < 2; ++_i) \
        __builtin_amdgcn_global_load_lds((const unsigned*)((const char*)(gbase) + (voff)[_i]), (PG8_LAS unsigned*)(lds + (bufoff) + ldsw + _i * 8192), 16, 0, 0); } while (0)
#define PG8_LDA(dst, b, h) do { _Pragma("unroll") for (int m = 0; m < 4; ++m) _Pragma("unroll") for (int k = 0; k < 2; ++k) dst[m][k] = *(const PG8_LAS bf16x8*)(lds + PG8_SA(b, h) + aoff + m * 2048 + k * 1024); } while (0)
#define PG8_LDB(dst, b, h) do { _Pragma("unroll") for (int n = 0; n < 2; ++n) _Pragma("unroll") for (int k = 0; k < 2; ++k) dst[n][k] = *(const PG8_LAS bf16x8*)(lds + PG8_SB(b, h) + boff + n * 2048 + k * 1024); } while (0)
#define PG8_MMA(ai, bj, At, Bt) do { __builtin_amdgcn_s_setprio(1); _Pragma("unroll") for (int m = 0; m < 4; ++m) _Pragma("unroll") for (int n = 0; n < 2; ++n) _Pragma("unroll") for (int k = 0; k < 2; ++k) \
        acc[ai][bj][m][n] = __builtin_amdgcn_mfma_f32_16x16x32_bf16(Bt[n][k], At[m][k], acc[ai][bj][m][n], 0, 0, 0); __builtin_amdgcn_s_setprio(0); } while (0)
#define PG8_WAIT_V(n) asm volatile("s_waitcnt vmcnt(" #n ")" ::: "memory")
#define PG8_WAIT_L(n) asm volatile("s_waitcnt lgkmcnt(" #n ")" ::: "memory")
#define PG8_BAR __builtin_amdgcn_s_barrier()
#define PG8_SCHED __builtin_amdgcn_sched_barrier(0)
    Unit cur, nxt; int ui = 0;
    if (!S.next(0, cur)) return;
    Acc acc;
#pragma unroll
    for (int a = 0; a < 2; ++a)
#pragma unroll
        for (int b = 0; b < 2; ++b)
#pragma unroll
            for (int m = 0; m < 4; ++m)
#pragma unroll
                for (int n = 0; n < 2; ++n) acc[a][b][m][n] = (f32x4){0.f, 0.f, 0.f, 0.f};
    bf16x8 At[4][2], B0[2][2], B1[2][2];
    const char* cA = (const char*)g.A + (size_t)cur.pm * tstepA; const char* cB = (const char*)g.Bt + (size_t)cur.pn * tstepB;
    PG8_STAGE(PG8_SB(0, 0), cB, voffB); PG8_STAGE(PG8_SB(0, 1), cB + hstepB, voffB); PG8_STAGE(PG8_SA(0, 0), cA, voffA); PG8_STAGE(PG8_SA(0, 1), cA + hstepA, voffA);
    if (wr == 1) PG8_BAR;
    PG8_WAIT_V(2); PG8_BAR;
    PG8_STAGE(PG8_SB(1, 0), cB + kstep, voffB); PG8_STAGE(PG8_SA(1, 0), cA + kstepA, voffA); PG8_STAGE(PG8_SB(1, 1), cB + hstepB + kstep, voffB);
    PG8_WAIT_V(6); PG8_BAR;
    for (;;) {
        const bool has_next = S.next(ui + 1, nxt);
        const char* nA = has_next ? (const char*)g.A + (size_t)nxt.pm * tstepA : cA; const char* nB = has_next ? (const char*)g.Bt + (size_t)nxt.pn * tstepB : cB;
        for (int t = 0; t < nt; t += 2) {
            const bool last = (t == nt - 2);
            const char* a1 = cA + (size_t)(t + 1) * kstepA;
            const char* a2 = last ? nA : cA + (size_t)(t + 2) * kstepA; const char* b2 = last ? nB : cB + (size_t)(t + 2) * kstep;
            const char* a3 = a2 + kstepA; const char* b3 = b2 + kstep;
            PG8_LDB(B0, 0, 0); PG8_LDB(B1, 0, 1); PG8_SCHED; PG8_LDA(At, 0, 0); PG8_STAGE(PG8_SA(1, 1), a1 + hstepA, voffA);
            PG8_WAIT_V(8); PG8_WAIT_L(0); PG8_BAR; PG8_MMA(0, 0, At, B0); PG8_MMA(0, 1, At, B1); PG8_BAR; PG8_SCHED;
            PG8_LDA(At, 0, 1); PG8_STAGE(PG8_SB(0, 0), b2, voffB); PG8_STAGE(PG8_SB(0, 1), b2 + hstepB, voffB); PG8_STAGE(PG8_SA(0, 0), a2, voffA);
            PG8_WAIT_V(8); PG8_WAIT_L(0); PG8_BAR; PG8_MMA(1, 0, At, B0); PG8_MMA(1, 1, At, B1); PG8_BAR; PG8_SCHED;
            PG8_LDB(B0, 1, 0); PG8_LDB(B1, 1, 1); PG8_SCHED; PG8_LDA(At, 1, 0); PG8_STAGE(PG8_SA(0, 1), a2 + hstepA, voffA);
            PG8_WAIT_V(8); PG8_WAIT_L(0); PG8_BAR; PG8_MMA(0, 0, At, B0); PG8_MMA(0, 1, At, B1); PG8_BAR; PG8_SCHED;
            PG8_LDA(At, 1, 1); PG8_STAGE(PG8_SB(1, 0), b3, voffB); PG8_STAGE(PG8_SB(1, 1), b3 + hstepB, voffB); PG8_STAGE(PG8_SA(1, 0), a3, voffA);
            PG8_WAIT_V(8); PG8_WAIT_L(0); PG8_BAR; PG8_MMA(1, 0, At, B0); PG8_MMA(1, 1, At, B1); PG8_BAR; PG8_SCHED;
            if constexpr (Epi::MIDK_T > 0) { if ((t + 2) % Epi::MIDK_T == 0 && t + 2 < nt) { E.mid(acc, cur, wr, wc, fr, fq, (t + 2) / Epi::MIDK_T); PG8_SCHED; } }
        }
        if (wr == 0) PG8_BAR;
        E(acc, cur, wr, wc, fr, fq);
        if (!has_next) break;
#pragma unroll
        for (int a = 0; a < 2; ++a)
#pragma unroll
            for (int b = 0; b < 2; ++b)
#pragma unroll
                for (int m = 0; m < 4; ++m)
#pragma unroll
                    for (int n = 0; n < 2; ++n) acc[a][b][m][n] = (f32x4){0.f, 0.f, 0.f, 0.f};
        cur = nxt; cA = nA; cB = nB; ++ui;
        if (wr == 1) PG8_BAR;
    }
    PG8_WAIT_V(0);
    PG8_BAR;
#undef PG8_SA
#undef PG8_SB
#undef PG8_STAGE
#undef PG8_LDA
#undef PG8_LDB
#undef PG8_MMA
#undef PG8_WAIT_V
#undef PG8_WAIT_L
#undef PG8_BAR
#undef PG8_SCHED
}
}
#define GAS __attribute__((address_space(1)))
#define LAS __attribute__((address_space(3)))
typedef unsigned short bf16;
typedef unsigned v4u __attribute__((ext_vector_type(4)));
typedef unsigned v2u __attribute__((ext_vector_type(2)));
typedef float f32x4 __attribute__((ext_vector_type(4)));
typedef short bf16x8 __attribute__((ext_vector_type(8)));
#define LDS_WAIT() asm volatile("s_waitcnt lgkmcnt(0)" ::: "memory")

constexpr int NWAVES = 8, NTHREADS = 512;
constexpr int BATCH = 16, SEQ = 2048, D = 1024, T = BATCH * SEQ, DFF = 2816, NMOD = 9;
constexpr int IN_W = 7440, N_PROJ1 = 5632, N_GATES = 2048, N_IN_PAD = 7680;
constexpr float EPS = 1e-6f;
constexpr size_t MiB = 1u << 20;
constexpr size_t WS_CTL = 0;
constexpr size_t WS_MOD = 1 * MiB;
constexpr size_t WS_W13_1 = 2 * MiB;
constexpr size_t WS_W2_1 = 13 * MiB;
constexpr size_t WS_WIN = 19 * MiB;
constexpr size_t WS_WB = 34 * MiB;
constexpr size_t WS_WOUT = 37 * MiB;
constexpr size_t WS_W13_2 = 39 * MiB;
constexpr size_t WS_W2_2 = 50 * MiB;
constexpr size_t WS_LSE = 56 * MiB;
constexpr size_t WS_SSQ = 58 * MiB;
constexpr size_t WS_GD = 66 * MiB;
constexpr size_t WS_U = 82 * MiB;
constexpr size_t WS_BIG = 146 * MiB;
constexpr size_t WS_HACT = WS_BIG;
constexpr size_t WS_Q = WS_BIG;
constexpr size_t WS_KV = WS_BIG + 48 * MiB;
constexpr size_t WS_GB = 290 * MiB;
constexpr size_t WS_GR = 418 * MiB;
constexpr size_t WS_EBL = 482 * MiB;
constexpr size_t WS_RQ = 483 * MiB;
constexpr size_t WS_END = 484 * MiB;
static_assert(WS_KV + (size_t)T * 12 * 128 * 2 <= WS_GB && WS_Q + (size_t)T * 768 * 2 <= WS_KV && WS_GB + (size_t)T * 2048 * 2 <= WS_GR && WS_W2_2 + (size_t)1024 * 2816 * 2 <= WS_LSE && WS_HACT + (size_t)T * DFF * 2 <= 512 * MiB && WS_END <= 512 * MiB, "ws map");

__device__ __forceinline__ unsigned f2bf(float f) { unsigned u = __builtin_bit_cast(unsigned, f); return (u + 0x7fffu + ((u >> 16) & 1u)) >> 16; }
__device__ __forceinline__ unsigned pk2(float lo, float hi) { return pg8::cvt_pk_bf16(lo, hi); }
__device__ __forceinline__ float bflo(unsigned w) { return __uint_as_float(w << 16); }
__device__ __forceinline__ float bfhi(unsigned w) { return __uint_as_float(w & 0xffff0000u); }
__device__ __forceinline__ float wave_sum(float v) {
#pragma unroll
    for (int o = 1; o < 64; o <<= 1) v += __shfl_xor(v, o);
    return v;
}

struct Args { const float* in[22]; float* out; unsigned char* ws; int ph_lo, ph_hi; };
#define PHASE_LOCAL(F) do { int l_ = __builtin_amdgcn_mbcnt_hi(~0u, __builtin_amdgcn_mbcnt_lo(~0u, 0u)); asm volatile("" : "+v"(l_)); (F).lane = l_; (F).tid = (F).wave * 64 + l_; } while (0)
struct Frame {
    LAS unsigned char* lds;
    int tid, lane, wave, vcu, G;
    const float* const* in; float* out; unsigned char* ws;
};
enum { I_X = 0, I_C, I_WMOD, I_BMOD, I_GFFN1, I_F1W1, I_F1W3, I_F1W2, I_GMIX, I_WIN, I_QNG, I_KNG, I_GUP, I_GBIAS, I_GONG, I_WBA, I_WBG, I_WOUT, I_GFFN2, I_F2W1, I_F2W3, I_F2W2 };

__device__ __forceinline__ void transpose_item(const float* W, int ldsrc, int k0, int nsrc0, int nvalid, bf16* dst, int drow0, int ldd, int dcol0, LAS float* scr, int lane) {
    const int n4 = 4 * (lane & 7);
    f32x4 tv[8];
#pragma unroll
    for (int i = 0; i < 8; ++i) { const int kk = 8 * i + (lane >> 3); tv[i] = (n4 < nvalid) ? *(const f32x4*)(W + (size_t)(k0 + kk) * ldsrc + nsrc0 + n4) : (f32x4){0.f, 0.f, 0.f, 0.f}; }
#pragma unroll
    for (int i = 0; i < 8; ++i) { const int kk = 8 * i + (lane >> 3); LAS float* sp = scr + kk * 33 + n4; sp[0] = tv[i][0]; sp[1] = tv[i][1]; sp[2] = tv[i][2]; sp[3] = tv[i][3]; }
    LDS_WAIT(); asm volatile("" ::: "memory");
    const int c = lane & 7;
#pragma unroll
    for (int jj = 0; jj < 4; ++jj) { const int n = (lane >> 3) + 8 * jj; const LAS float* s = scr + (8 * c) * 33 + n;
        v4u o; o.x = pk2(s[0 * 33], s[1 * 33]); o.y = pk2(s[2 * 33], s[3 * 33]); o.z = pk2(s[4 * 33], s[5 * 33]); o.w = pk2(s[6 * 33], s[7 * 33]);
        if (n < nvalid) *(GAS v4u*)(dst + (size_t)(drow0 + n) * ldd + dcol0 + k0 + 8 * c) = o; }
    LDS_WAIT(); asm volatile("" ::: "memory");
}
constexpr int FFN_ITEMS = 3 * 1408;
__device__ __forceinline__ void ffn_weight_item(const float* w1, const float* w3, const float* w2, bf16* W13, bf16* W2, int r, LAS float* scr, int lane) {
    if (r < 2816) { const int which = r / 1408, q = r % 1408, kb = q / 88, nb = q % 88, n0 = nb * 32;
        transpose_item(which ? w3 : w1, DFF, kb * 64, n0, 32, W13, (n0 >> 7) * 256 + (n0 & 127) + which * 128, 1024, 0, scr, lane); }
    else { const int q = r - 2816, kb = q / 32, nb = q % 32; transpose_item(w2, D, kb * 64, nb * 32, 32, W2, nb * 32, DFF, 0, scr, lane); }
}
__device__ __forceinline__ void p0_prologue(Frame& F) {
    PHASE_LOCAL(F);
    LAS float* scr = (LAS float*)(F.lds + F.wave * 16384);
    const int gw = F.vcu * NWAVES + F.wave, NGW = F.G * NWAVES;
    bf16* W13_1 = (bf16*)(F.ws + WS_W13_1); bf16* W2_1 = (bf16*)(F.ws + WS_W2_1); bf16* WIN = (bf16*)(F.ws + WS_WIN); bf16* WB = (bf16*)(F.ws + WS_WB);
    bf16* WOUT = (bf16*)(F.ws + WS_WOUT); bf16* W13_2 = (bf16*)(F.ws + WS_W13_2); bf16* W2_2 = (bf16*)(F.ws + WS_W2_2);
    constexpr int I_IN = 16 * (168 + 1 + 64), I_BA = 4 * 32, I_BG = 16 * 32, I_OUT = 16 * 32, I_PAD = 240;
    constexpr int NITEMS = 2 * FFN_ITEMS + I_IN + I_BA + I_BG + I_OUT + I_PAD;
    const bool bal = F.G == 256, modwg = F.vcu < 144;
    const int nslots = !bal ? 1 : modwg ? 3 : 6, sbase = !bal ? gw : (modwg ? F.vcu * NWAVES * 3 : 144 * NWAVES * 3 + (F.vcu - 144) * NWAVES * 6) + F.wave;
    const int NSLOTS = bal ? 144 * NWAVES * 3 + 112 * NWAVES * 6 : NGW;
    for (int ks = 0; ks < nslots; ++ks)
    for (int it = sbase + ks * (bal ? NWAVES : 1); it < NITEMS; it += NSLOTS) {
        int r = it;
        if (r < FFN_ITEMS) { ffn_weight_item(F.in[I_F1W1], F.in[I_F1W3], F.in[I_F1W2], W13_1, W2_1, r, scr, F.lane); continue; } r -= FFN_ITEMS;
        if (r < FFN_ITEMS) { ffn_weight_item(F.in[I_F2W1], F.in[I_F2W3], F.in[I_F2W2], W13_2, W2_2, r, scr, F.lane); continue; } r -= FFN_ITEMS;
        if (r < I_IN) { const int kb = r / 233, nb = r % 233;
            if (nb < 168) { int drow = nb * 32;
                if (drow >= 768 && drow < 1536) drow = 768 + ((drow - 768) >> 6) * 128 + ((drow - 768) & 63);
                else if (drow >= 1536 && drow < 2304) drow = 768 + ((drow - 1536) >> 6) * 128 + 64 + ((drow - 1536) & 63);
                transpose_item(F.in[I_WIN], IN_W, kb * 64, nb * 32, 32, WIN, drow, 1024, 0, scr, F.lane); }
            else if (nb == 168) transpose_item(F.in[I_WIN], IN_W, kb * 64, 5376, 16, WIN, 5376, 1024, 0, scr, F.lane);
            else { const int j = (nb - 169) * 32, jj = j & 1023;
                transpose_item(F.in[I_WIN], IN_W, kb * 64, 5392 + j, 32, WIN, N_PROJ1 + (jj >> 7) * 256 + (j >= 1024 ? 128 : 0) + (jj & 127), 1024, 0, scr, F.lane); }
            continue; } r -= I_IN;
        if (r < I_BA) { const int kb = r / 32, nb = r % 32; transpose_item(F.in[I_WBA], D, kb * 64, nb * 32, 32, WB, nb * 32, 1280, 0, scr, F.lane); continue; } r -= I_BA;
        if (r < I_BG) { const int kb = r / 32, nb = r % 32; transpose_item(F.in[I_WBG], D, kb * 64, nb * 32, 32, WB, nb * 32, 1280, 256, scr, F.lane); continue; } r -= I_BG;
        if (r < I_OUT) { const int kb = r / 32, nb = r % 32; transpose_item(F.in[I_WOUT], D, kb * 64, nb * 32, 32, WOUT, nb * 32, 1024, 0, scr, F.lane); continue; } r -= I_OUT;
        { GAS v4u* row = (GAS v4u*)(WIN + (size_t)(5392 + r) * 1024); const v4u z = {0u, 0u, 0u, 0u}; row[F.lane] = z; row[64 + F.lane] = z; }
    }
}
__device__ __forceinline__ void p0_mod(Frame& F) {
    __syncthreads();
    if (F.vcu < 144) {
        LAS float* cat = (LAS float*)F.lds;
        LAS float* red = (LAS float*)(F.lds + 65536);
        const float* c = F.in[I_C];
        {   float cv[32];
#pragma unroll
            for (int i = 0; i < 32; ++i) cv[i] = c[F.tid + NTHREADS * i];
#pragma unroll
            for (int i = 0; i < 32; ++i) { const int e = F.tid + NTHREADS * i; cat[(e & 1023) * 16 + (e >> 10)] = cv[i] / (1.f + __expf(-cv[i])); } }
        __syncthreads();
        const int n4 = F.lane & 15, bg = F.lane >> 4, kb = F.wave * 128;
        const float* w = F.in[I_WMOD] + F.vcu * 64 + 4 * n4;
        f32x4 acc[4];
#pragma unroll
        for (int bi = 0; bi < 4; ++bi) acc[bi] = (f32x4){0.f, 0.f, 0.f, 0.f};
        f32x4 wv[2][16];
#pragma unroll
        for (int i = 0; i < 16; ++i) wv[0][i] = *(const f32x4*)(w + (size_t)(kb + i) * (NMOD * D));
#pragma unroll
        for (int gi = 0; gi < 8; ++gi) { const int k0 = 16 * gi;
            if (gi < 7) {
#pragma unroll
                for (int i = 0; i < 16; ++i) wv[(gi + 1) & 1][i] = *(const f32x4*)(w + (size_t)(kb + k0 + 16 + i) * (NMOD * D)); }
#pragma unroll
            for (int i = 0; i < 16; ++i) { const f32x4 cb = *(const LAS f32x4*)(cat + (kb + k0 + i) * 16 + 4 * bg);
#pragma unroll
                for (int bi = 0; bi < 4; ++bi) acc[bi] += wv[gi & 1][i] * cb[bi]; } }
#pragma unroll
        for (int bi = 0; bi < 4; ++bi) *(LAS f32x4*)(red + (F.wave * 16 + 4 * bg + bi) * 64 + 4 * n4) = acc[bi];
        __syncthreads();
        float* mod = (float*)(F.ws + WS_MOD);
        for (int i = F.tid; i < 16 * 64; i += NTHREADS) { const int b = i >> 6, l = i & 63; float s = 0.f;
#pragma unroll
            for (int wv = 0; wv < 8; ++wv) s += red[(wv * 16 + b) * 64 + l];
            mod[b * (NMOD * D) + F.vcu * 64 + l] = s + F.in[I_BMOD][F.vcu * 64 + l]; }
    }
}
template <bool IN_BF16> __device__ __forceinline__ void norm_phase(Frame& F, const void* X, const float* g, int sh_idx, bf16* U) {
    PHASE_LOCAL(F);
    const int gw = F.vcu * NWAVES + F.wave;
    const int row0 = gw * 16, b = row0 >> 11;
    const float* mod = (const float*)(F.ws + WS_MOD) + (size_t)b * (NMOD * D);
    f32x4 gam[4], shv[4];
#pragma unroll
    for (int j = 0; j < 4; ++j) { const int col = 8 * F.lane + 512 * (j >> 1) + 4 * (j & 1); const f32x4 gg = *(const f32x4*)(g + col), sc = *(const f32x4*)(mod + (sh_idx + 1) * D + col);
        gam[j] = gg * (sc + 1.0f); shv[j] = *(const f32x4*)(mod + sh_idx * D + col); }
    typedef typename std::conditional<IN_BF16, v4u, f32x4>::type raw_t;
    constexpr int NRAW = IN_BF16 ? 2 : 4;
    raw_t raw[2][4][NRAW];
#define NP_LOAD(buf, r0) do { _Pragma("unroll") for (int rr = 0; rr < 4; ++rr) { \
        if (IN_BF16) { const GAS v4u* xr = (const GAS v4u*)((const bf16*)X + (size_t)(row0 + (r0) + rr) * D) + F.lane; \
            _Pragma("unroll") for (int h2 = 0; h2 < 2; ++h2) raw[buf][rr][h2] = __builtin_bit_cast(raw_t, xr[64 * h2]); } \
        else { const GAS f32x4* xr = (const GAS f32x4*)((const float*)X + (size_t)(row0 + (r0) + rr) * D) + 2 * F.lane; \
            _Pragma("unroll") for (int h2 = 0; h2 < 2; ++h2) { raw[buf][rr][(2 * h2) % NRAW] = __builtin_bit_cast(raw_t, __builtin_nontemporal_load((const f32x4*)(xr + 128 * h2))); raw[buf][rr][(2 * h2 + 1) % NRAW] = __builtin_bit_cast(raw_t, __builtin_nontemporal_load((const f32x4*)(xr + 128 * h2 + 1))); } } } } while (0)
    NP_LOAD(0, 0);
#pragma unroll
    for (int gi = 0; gi < 4; ++gi) {
        if (gi < 3) NP_LOAD((gi + 1) & 1, 4 * (gi + 1));
#pragma unroll
        for (int rr = 0; rr < 4; ++rr) { const int r = 4 * gi + rr;
            f32x4 v[4]; float s = 0.f;
            if (IN_BF16) {
#pragma unroll
                for (int h2 = 0; h2 < 2; ++h2) { const v4u t = __builtin_bit_cast(v4u, raw[gi & 1][rr][h2 % NRAW]);
                    v[2 * h2] = (f32x4){bflo(t.x), bfhi(t.x), bflo(t.y), bfhi(t.y)}; v[2 * h2 + 1] = (f32x4){bflo(t.z), bfhi(t.z), bflo(t.w), bfhi(t.w)}; } }
            else {
#pragma unroll
                for (int j = 0; j < 4; ++j) v[j] = __builtin_bit_cast(f32x4, raw[gi & 1][rr][j % NRAW]); }
#pragma unroll
            for (int j = 0; j < 4; ++j) s += (v[j].x * v[j].x + v[j].y * v[j].y) + (v[j].z * v[j].z + v[j].w * v[j].w);
            const float rstd = 1.f / sqrtf(wave_sum(s) * (1.f / D) + EPS);
            GAS v4u* o16 = (GAS v4u*)(U + (size_t)(row0 + r) * D) + F.lane;
#pragma unroll
            for (int h2 = 0; h2 < 2; ++h2) { const f32x4 y0 = v[2 * h2] * rstd * gam[2 * h2] + shv[2 * h2], y1 = v[2 * h2 + 1] * rstd * gam[2 * h2 + 1] + shv[2 * h2 + 1];
                v4u w; w.x = pk2(y0.x, y0.y); w.y = pk2(y0.z, y0.w); w.z = pk2(y1.x, y1.y); w.w = pk2(y1.z, y1.w); o16[64 * h2] = w; }
        }
    }
#undef NP_LOAD
}
#define XB_TMO      128
#define XB_XCNT(j)  (256  + 64 * (j))
#define XB_XSUB(j)  (1280 + 64 * (j))
#define XB_XGEN(j)  (2304 + 64 * (j))
#define XB_TOP      3328
#define XB_TOPGEN   3392
#define XCD_BAR_WORDS 3456
#define XB_SPIN_CAP (1u << 22)
__device__ __forceinline__ unsigned xb_ld(unsigned* p)              { return __hip_atomic_load(p, __ATOMIC_RELAXED, __HIP_MEMORY_SCOPE_AGENT); }
__device__ __forceinline__ unsigned xb_add(unsigned* p, unsigned v) { return __hip_atomic_fetch_add(p, v, __ATOMIC_RELAXED, __HIP_MEMORY_SCOPE_AGENT); }
__device__ __forceinline__ unsigned xb_xcc_id() { return (unsigned)__builtin_amdgcn_s_getreg((3 << 11) | 20) & 0xFu; }
#define XB_SPIN(cond, bar) do { unsigned _sp = 0; while (cond) { __builtin_amdgcn_s_sleep(1); \
    if ((++_sp & 255u) == 0u) { if (xb_ld(&(bar)[XB_TMO])) break; if (_sp > XB_SPIN_CAP) { atomicAdd(&(bar)[XB_TMO], 1u); break; } } } } while (0)
struct XcdBarrier { unsigned* bar; unsigned x; volatile LAS unsigned* st; };
__device__ __forceinline__ XcdBarrier xcd_barrier_post(unsigned* bar, volatile LAS unsigned* st, bool leader) {
    XcdBarrier b; b.bar = bar; b.x = xb_xcc_id(); b.st = st;
    if (leader) (void)xb_add(&bar[XB_XCNT(b.x)], 1u);
    return b;
}
__device__ __forceinline__ void xcd_barrier_complete(unsigned* bar, unsigned x, unsigned& nloc, unsigned& nx) {
    const unsigned G = gridDim.x;
    unsigned sum, cnt, mine, sp = 0u;
    for (;;) {
        sum = 0u; cnt = 0u; mine = 0u;
#pragma unroll
        for (unsigned j = 0; j < 16; ++j) { const unsigned c = xb_ld(&bar[XB_XCNT(j)]); sum += c; cnt += (c > 0u) ? 1u : 0u; mine = (j == x) ? c : mine; }
        if (sum == G) break;
        __builtin_amdgcn_s_sleep(1);
        if ((++sp & 255u) == 0u) { if (xb_ld(&bar[XB_TMO])) break; if (sp > XB_SPIN_CAP) { atomicAdd(&bar[XB_TMO], 1u); break; } }
    }
    nloc = mine > 0u ? mine : 1u; nx = cnt > 0u ? cnt : 1u;
}
__device__ __forceinline__ void xcd_barrier(const XcdBarrier& b, bool leader  ) {
    asm volatile("s_waitcnt vmcnt(0)" ::: "memory");
    __syncthreads();
    if (leader) {
        unsigned* bar = b.bar;
        __builtin_amdgcn_s_waitcnt(0);
        unsigned nloc = b.st[0], nx = b.st[1];
        if (nloc == 0u) { xcd_barrier_complete(bar, b.x, nloc, nx); b.st[0] = nloc; b.st[1] = nx; }
        const unsigned old = xb_add(&bar[XB_XSUB(b.x)], 1u);
        const unsigned gen = old / nloc;
        if (old + 1u == (gen + 1u) * nloc) {
            __builtin_amdgcn_fence(__ATOMIC_RELEASE, "agent");
            asm volatile("s_waitcnt vmcnt(0)" ::: "memory");
            const unsigned og = xb_add(&bar[XB_TOP], 1u);
            const unsigned tg = og / nx;
            if (og + 1u == (tg + 1u) * nx) {
#pragma unroll
                for (int j = 0; j < 16; ++j) xb_add(&bar[XB_XGEN(j)], 1u); }
            else XB_SPIN(xb_ld(&bar[XB_XGEN(b.x)]) == gen, bar);
            __builtin_amdgcn_fence(__ATOMIC_ACQUIRE, "agent");
            asm volatile("s_waitcnt vmcnt(0)" ::: "memory");
        } else {
            XB_SPIN(xb_ld(&bar[XB_XGEN(b.x)]) == gen, bar);
            __builtin_amdgcn_fence(__ATOMIC_ACQUIRE, "agent");
            asm volatile("s_waitcnt vmcnt(0)" ::: "memory");
        }
    }
    __syncthreads();
}
typedef float f32x16 __attribute__((ext_vector_type(16)));
typedef short s16x4 __attribute__((ext_vector_type(4)));
typedef short v4i16_t __attribute__((ext_vector_type(4)));
constexpr float LOG2E = 1.4426950408889634f, LN2 = 0.6931471805599453f;
__device__ __forceinline__ s16x4 lds_tr(LAS const unsigned char* p) { return __builtin_bit_cast(s16x4, __builtin_amdgcn_ds_read_tr16_b64_v4i16((LAS v4i16_t*)p)); }
__device__ __forceinline__ bf16x8 cat44(s16x4 a, s16x4 b) { return (bf16x8){a[0], a[1], a[2], a[3], b[0], b[1], b[2], b[3]}; }
#define DPP_SHR(x, n) __builtin_bit_cast(float, __builtin_amdgcn_update_dpp(0, __builtin_bit_cast(int, (x)), 0x110 + (n), 0xf, 0xf, false))

template <bool DRY> __device__ __forceinline__ void gla_prep(Frame& F) {
    PHASE_LOCAL(F);
    const int w = F.wave, lane = F.lane, t15 = lane & 15, g = lane >> 4;
    bf16* GB = (bf16*)(F.ws + WS_GB); const bf16* GD = (const bf16*)(F.ws + WS_GD); float* EBL = (float*)(F.ws + WS_EBL);
    const int h = (F.vcu >> 5) & 3;
    bf16x8 gupA = (bf16x8){0, 0, 0, 0, 0, 0, 0, 0};
    if (g < 2) { const float* gu = F.in[I_GUP] + h * 128 + 16 * w + t15;
#pragma unroll
        for (int jj = 0; jj < 8; ++jj) gupA[jj] = (short)f2bf(gu[(size_t)(8 * g + jj) * 512]); }
    float zb[4];
#pragma unroll
    for (int j = 0; j < 4; ++j) zb[j] = F.in[I_GBIAS][h * 128 + 16 * w + 4 * g + j];
    v4u rawq[2], rawk[2]; v4u gdf[4];
#define GP_LOAD(item_) do { const int bh_ = (item_) >> 5, c_ = (item_) & 31; const size_t r0_ = (size_t)(bh_ >> 2) * SEQ + c_ * 64; \
        _Pragma("unroll") for (int pp = 0; pp < 2; ++pp) { const bf16* rp = GB + (r0_ + 16 * (2 * pp + (g & 1)) + t15) * 2048 + h * 128 + 16 * w + 8 * (g >> 1); \
            rawq[pp] = *(const v4u*)rp; rawk[pp] = *(const v4u*)(rp + 512); } \
        _Pragma("unroll") for (int ti = 0; ti < 4; ++ti) { const size_t tr_ = r0_ + 16 * ti + t15; \
            gdf[ti] = (g < 2) ? *(const v4u*)(GD + tr_ * 256 + 8 * g) : (v4u){0u, 0u, 0u, 0u}; } } while (0)
    GP_LOAD(F.vcu);
    for (int it = 0; it < 8; ++it) {
        const int item = F.vcu + 256 * it, bh = item >> 5, c = item & 31, b = bh >> 2;
        const size_t row0 = (size_t)b * SEQ + c * 64;
        v2u qf[4], kf[4];
#pragma unroll
        for (int pp = 0; pp < 2; ++pp) {
            const auto qx = __builtin_amdgcn_permlane16_swap(rawq[pp].x, rawq[pp].z, false, false), qy = __builtin_amdgcn_permlane16_swap(rawq[pp].y, rawq[pp].w, false, false);
            const auto kx = __builtin_amdgcn_permlane16_swap(rawk[pp].x, rawk[pp].z, false, false), ky = __builtin_amdgcn_permlane16_swap(rawk[pp].y, rawk[pp].w, false, false);
            qf[2 * pp] = (v2u){qx[0], qy[0]}; qf[2 * pp + 1] = (v2u){qx[1], qy[1]}; kf[2 * pp] = (v2u){kx[0], ky[0]}; kf[2 * pp + 1] = (v2u){kx[1], ky[1]}; }
        float bq[4][4];
#pragma unroll
        for (int ti = 0; ti < 4; ++ti) {
            pg8::f32x4 z = __builtin_amdgcn_mfma_f32_16x16x32_bf16(gupA, __builtin_bit_cast(bf16x8, gdf[ti]), (pg8::f32x4){0.f, 0.f, 0.f, 0.f}, 0, 0, 0);
#pragma unroll
            for (int j = 0; j < 4; ++j) { const float zz = z[j] + zb[j];
                float x = (fminf(zz, 0.f) * LOG2E - __builtin_amdgcn_logf(1.f + __builtin_amdgcn_exp2f(-fabsf(zz) * LOG2E))) * (1.f / 16.f);
                x += DPP_SHR(x, 1); x += DPP_SHR(x, 2); x += DPP_SHR(x, 4); x += DPP_SHR(x, 8);
                bq[ti][j] = x; }
        }
        float bl[4];
#pragma unroll
        for (int j = 0; j < 4; ++j) { float carry = 0.f;
#pragma unroll
            for (int ti = 0; ti < 4; ++ti) { const float tot = __shfl(bq[ti][j], (lane & 48) | 15); bq[ti][j] += carry; carry += tot; }
            bl[j] = carry; }
        v2u oq[4], ok[4];
#pragma unroll
        for (int ti = 0; ti < 4; ++ti) {
            const float q0 = bflo(qf[ti].x), q1 = bfhi(qf[ti].x), q2 = bflo(qf[ti].y), q3 = bfhi(qf[ti].y);
            const float k0 = bflo(kf[ti].x), k1 = bfhi(kf[ti].x), k2 = bflo(kf[ti].y), k3 = bfhi(kf[ti].y);
            float e[4], ei[4];
#pragma unroll
            for (int j = 0; j < 4; ++j) { e[j] = __builtin_amdgcn_exp2f(bq[ti][j]) * 0.08838834764831845f; ei[j] = __builtin_amdgcn_exp2f(-bq[ti][j]); }
            oq[ti].x = pg8::cvt_pk_bf16(q0 * e[0], q1 * e[1]); oq[ti].y = pg8::cvt_pk_bf16(q2 * e[2], q3 * e[3]);
            ok[ti].x = pg8::cvt_pk_bf16(k0 * ei[0], k1 * ei[1]); ok[ti].y = pg8::cvt_pk_bf16(k2 * ei[2], k3 * ei[3]);
        }
        if (it < 7) GP_LOAD(item + 256);
        if (DRY) {
#pragma unroll
            for (int ti = 0; ti < 4; ++ti) asm volatile("" :: "v"(oq[ti].x), "v"(oq[ti].y), "v"(ok[ti].x), "v"(ok[ti].y));
            asm volatile("" :: "v"(bl[0]), "v"(bl[1]), "v"(bl[2]), "v"(bl[3])); continue; }
#pragma unroll
        for (int pp = 0; pp < 2; ++pp) {
            const auto qx = __builtin_amdgcn_permlane16_swap(oq[2 * pp].x, oq[2 * pp + 1].x, false, false), qy = __builtin_amdgcn_permlane16_swap(oq[2 * pp].y, oq[2 * pp + 1].y, false, false);
            const auto kx = __builtin_amdgcn_permlane16_swap(ok[2 * pp].x, ok[2 * pp + 1].x, false, false), ky = __builtin_amdgcn_permlane16_swap(ok[2 * pp].y, ok[2 * pp + 1].y, false, false);
            bf16* rp = GB + (row0 + 16 * (2 * pp + (g & 1)) + t15) * 2048 + h * 128 + 16 * w + 8 * (g >> 1);
            *(v4u*)rp = (v4u){qx[0], qy[0], qx[1], qy[1]}; *(v4u*)(rp + 512) = (v4u){kx[0], ky[0], kx[1], ky[1]}; }
        if (t15 == 0) { f32x4 ev; ev[0] = __builtin_amdgcn_exp2f(bl[0]); ev[1] = __builtin_amdgcn_exp2f(bl[1]); ev[2] = __builtin_amdgcn_exp2f(bl[2]); ev[3] = __builtin_amdgcn_exp2f(bl[3]);
            *(f32x4*)(EBL + (size_t)item * 128 + 16 * w + 4 * g) = ev; }
    }
#undef GP_LOAD
}
#define LDS_BARRIER() do { asm volatile("s_waitcnt lgkmcnt(0)" ::: "memory"); __builtin_amdgcn_s_barrier(); asm volatile("" ::: "memory"); } while (0)
constexpr int G2_QD = 0, G2_KI = 34816, G2_V = 69632, G2_ST = 88064, G2_OB = 122880, G2_SS = 141312;
template <bool DRY> __device__ __forceinline__ void gla_chain2(Frame& F) {
    PHASE_LOCAL(F);
    const int w = F.wave, lane = F.lane, t15 = lane & 15, g = lane >> 4, tid = F.tid;
    const int bh = F.vcu >> 2, b = bh >> 2, h = bh & 3, sl = F.vcu & 3;
    LAS unsigned char* lds = F.lds;
    bf16* GB = (bf16*)(F.ws + WS_GB); float* SSQ = (float*)(F.ws + WS_SSQ); const float* EBL = (const float*)(F.ws + WS_EBL) + (size_t)bh * 32 * 128;
    const size_t row0 = (size_t)b * SEQ;
    const bool flw = (w < 2) || (w >= 6); const int fl = ((w < 2) ? w : w - 4) * 64 + lane;
    const bf16* GRg = (const bf16*)(F.ws + WS_GR); v4u gtA[2] = {{0u, 0u, 0u, 0u}, {0u, 0u, 0u, 0u}}, gtB[2] = {{0u, 0u, 0u, 0u}, {0u, 0u, 0u, 0u}};
    v4u sqA[2], skA[2], svA, sqB[2], skB[2], svB; f32x4 ebA, ebB;
#define G2_LOAD(c, sq, sk, sv, ebn) do { const int c_ = (c); \
        _Pragma("unroll") for (int i = 0; i < 2; ++i) { const int p = tid + 512 * i; const bf16* rp = GB + (row0 + c_ * 64 + (p >> 4)) * 2048 + h * 128 + (p & 15) * 8; sq[i] = *(const v4u*)rp; sk[i] = *(const v4u*)(rp + 512); } \
        sv = *(const v4u*)(GB + (row0 + c_ * 64 + (tid >> 3)) * 2048 + 1024 + h * 256 + 64 * sl + 8 * (tid & 7)); \
        ebn = *(const f32x4*)(EBL + c_ * 128 + 16 * w + 4 * g); } while (0)
#define G2_STORE(buf, sq, sk, sv) do { const int b_ = (buf); \
        _Pragma("unroll") for (int i = 0; i < 2; ++i) { const int p = tid + 512 * i; *(LAS v4u*)(lds + G2_QD + b_ * 17408 + (p >> 4) * 272 + (p & 15) * 16) = sq[i]; *(LAS v4u*)(lds + G2_KI + b_ * 17408 + (p >> 4) * 272 + (p & 15) * 16) = sk[i]; } \
        *(LAS v4u*)(lds + G2_V + b_ * 9216 + (tid >> 3) * 144 + (tid & 7) * 16) = sv; } while (0)
#define G2_GATE(c, gt) do { if (flw) { _Pragma("unroll") for (int k_ = 0; k_ < 2; ++k_) { const int p_ = fl + 256 * k_; \
        gt[k_] = *(const v4u*)(GRg + (row0 + (c) * 64 + (p_ >> 3)) * 1024 + h * 256 + 64 * sl + 8 * (p_ & 7)); } } } while (0)
#define G2_MULG(ow, gw) pk2(bflo(ow) * bflo(gw), bfhi(ow) * bfhi(gw))
#define G2_FLUSH(c, buf, gt) do { if (!DRY && flw) { const int c_ = (c), o_ = (buf); \
        _Pragma("unroll") for (int k_ = 0; k_ < 2; ++k_) { const int p_ = fl + 256 * k_; const size_t tr_ = row0 + c_ * 64 + (p_ >> 3); \
            const v4u ov_ = *(const LAS v4u*)(lds + G2_OB + o_ * 9216 + (p_ >> 3) * 144 + (p_ & 7) * 16); \
            *(v4u*)(GB + tr_ * 2048 + 1024 + h * 256 + 64 * sl + 8 * (p_ & 7)) = (v4u){G2_MULG(ov_.x, gt[k_].x), G2_MULG(ov_.y, gt[k_].y), G2_MULG(ov_.z, gt[k_].z), G2_MULG(ov_.w, gt[k_].w)}; } \
        if (tid < 64) *(f32x4*)(SSQ + (row0 + c_ * 64 + tid) * 64 + h * 16 + sl * 4) = *(const LAS f32x4*)(lds + G2_SS + o_ * 1024 + tid * 16); } } while (0)
    pg8::f32x4 acc[4];
#pragma unroll
    for (int i = 0; i < 4; ++i) acc[i] = (pg8::f32x4){0.f, 0.f, 0.f, 0.f};
    G2_LOAD(0, sqA, skA, svA, ebA); G2_STORE(0, sqA, skA, svA);
    f32x4 ebc = ebA;
#pragma unroll
    for (int dvt = 0; dvt < 4; ++dvt) *(LAS v2u*)(lds + G2_ST + (16 * dvt + t15) * 272 + (16 * w + 4 * g) * 2) = (v2u){0u, 0u};
    G2_LOAD(1, sqA, skA, svA, ebA); G2_LOAD(2, sqB, skB, svB, ebB);
    __syncthreads();
    const int tt = (w < 4) ? w : 7 - w, dvh = w >> 2;
    for (int c2 = 0; c2 < 32; c2 += 2) {
#pragma unroll
        for (int par = 0; par < 2; ++par) {
            const int c = c2 + par;
        const int bb = c & 1, qd = G2_QD + bb * 17408, ki = G2_KI + bb * 17408, vb = G2_V + bb * 9216, st = G2_ST + bb * 17408, stn = G2_ST + (bb ^ 1) * 17408;
            {
                bf16x8 qf[4];
#pragma unroll
                for (int ks = 0; ks < 4; ++ks) qf[ks] = *(const LAS bf16x8*)(lds + qd + (16 * tt + t15) * 272 + (32 * ks + 8 * g) * 2);
                v2u ap[4];
#pragma unroll
                for (int tj = 0; tj < 4; ++tj) {
                    pg8::f32x4 d = (pg8::f32x4){0.f, 0.f, 0.f, 0.f};
                    if (tj <= tt) {
#pragma unroll
                        for (int ks = 0; ks < 4; ++ks) {
                            const bf16x8 a = *(const LAS bf16x8*)(lds + ki + (16 * tj + t15) * 272 + (32 * ks + 8 * g) * 2);
                            d = __builtin_amdgcn_mfma_f32_16x16x32_bf16(a, qf[ks], d, 0, 0, 0); }
                        if (tj == tt) {
#pragma unroll
                            for (int j = 0; j < 4; ++j) if (4 * g + j > t15) d[j] = 0.f; }
                    }
                    ap[tj].x = pk2(d[0], d[1]); ap[tj].y = pk2(d[2], d[3]); }
#pragma unroll
                for (int dd = 0; dd < 2; ++dd) { const int dvo = 2 * dvh + dd;
                    pg8::f32x4 d = (pg8::f32x4){0.f, 0.f, 0.f, 0.f};
#pragma unroll
                    for (int ks = 0; ks < 4; ++ks) {
                        const bf16x8 a = *(const LAS bf16x8*)(lds + st + (16 * dvo + t15) * 272 + (32 * ks + 8 * g) * 2);
                        d = __builtin_amdgcn_mfma_f32_16x16x32_bf16(a, qf[ks], d, 0, 0, 0); }
#pragma unroll
                    for (int ks = 0; ks < 2; ++ks) {
                        if (ks == 1 && tt < 2) continue;
                        LAS const unsigned char* va = lds + vb + (32 * ks + 4 * g + (t15 >> 2)) * 144 + (16 * dvo + 4 * (lane & 3)) * 2;
                        const bf16x8 a = cat44(lds_tr(va), lds_tr(va + 16 * 144));
                        const v4u bw = {ap[2 * ks].x, ap[2 * ks].y, ap[2 * ks + 1].x, ap[2 * ks + 1].y};
                        d = __builtin_amdgcn_mfma_f32_16x16x32_bf16(a, __builtin_bit_cast(bf16x8, bw), d, 0, 0, 0); }
                    v2u o; o.x = pk2(d[0], d[1]); o.y = pk2(d[2], d[3]);
                    float ss = (d[0] * d[0] + d[1] * d[1]) + (d[2] * d[2] + d[3] * d[3]);
                    ss += __shfl_xor(ss, 16); ss += __shfl_xor(ss, 32);
                    *(LAS v2u*)(lds + G2_OB + bb * 9216 + (16 * tt + t15) * 144 + (16 * dvo + 4 * g) * 2) = o;
                    if (g == 0) *(LAS float*)(lds + G2_SS + bb * 1024 + ((16 * tt + t15) * 4 + dvo) * 4) = ss; }
            }
            if (c > 0) { if (par == 0) G2_FLUSH(c - 1, bb ^ 1, gtB); else G2_FLUSH(c - 1, bb ^ 1, gtA); }
#pragma unroll
            for (int ks = 0; ks < 2; ++ks) {
                const int trow = 32 * ks + 8 * g + (t15 >> 2);
                LAS const unsigned char* ka = lds + ki + trow * 272 + (16 * w + 4 * (lane & 3)) * 2;
                const bf16x8 a = cat44(lds_tr(ka), lds_tr(ka + 4 * 272));
#pragma unroll
                for (int dvt = 0; dvt < 4; ++dvt) { LAS const unsigned char* va = lds + vb + trow * 144 + (16 * dvt + 4 * (lane & 3)) * 2;
                    const bf16x8 bbf = cat44(lds_tr(va), lds_tr(va + 4 * 144));
                    acc[dvt] = __builtin_amdgcn_mfma_f32_16x16x32_bf16(a, bbf, acc[dvt], 0, 0, 0); }
            }
#pragma unroll
            for (int dvt = 0; dvt < 4; ++dvt) {
#pragma unroll
                for (int j = 0; j < 4; ++j) acc[dvt][j] *= ebc[j];
                v2u o; o.x = pk2(acc[dvt][0], acc[dvt][1]); o.y = pk2(acc[dvt][2], acc[dvt][3]);
                *(LAS v2u*)(lds + stn + (16 * dvt + t15) * 272 + (16 * w + 4 * g) * 2) = o; }
            if (par == 0) { G2_GATE(c, gtA); G2_STORE(bb ^ 1, sqA, skA, svA); ebc = ebA; G2_LOAD(c < 29 ? c + 3 : 31, sqA, skA, svA, ebA); }
            else { G2_GATE(c, gtB); G2_STORE(bb ^ 1, sqB, skB, svB); ebc = ebB; G2_LOAD(c < 29 ? c + 3 : 31, sqB, skB, svB, ebB); }
            LDS_BARRIER();
        }
    }
    G2_FLUSH(31, 1, gtB);
#undef G2_LOAD
#undef G2_STORE
#undef G2_FLUSH
#undef G2_GATE
#undef G2_MULG
}
constexpr int AT_TAB = 131072;
template <bool DRY> __device__ __forceinline__ void attn_units(Frame& F) {
    PHASE_LOCAL(F);
    const int tid = F.tid, lane = F.lane, w = F.wave, half = w >> 2, hw = w & 3, r32 = lane & 31, hi = lane >> 5;
    LAS unsigned char* lds = F.lds;
    bf16* Q = (bf16*)(F.ws + WS_Q); const bf16* KV = (const bf16*)(F.ws + WS_KV); float* LSE = (float*)(F.ws + WS_LSE);
    LAS unsigned char* Ks = lds; LAS unsigned char* Vs = lds + 49152;
    LAS unsigned char* Kb = Ks + half * 16384; LAS unsigned char* Vb = Vs + half * 16384;
    const int qi = 32 * hw + r32, a0 = hw >> 1;
#define AT_DECODE(it_) const int P_ = F.vcu + 256 * (it_), p8_ = P_ & 7, bhh_ = P_ >> 3, b_ = bhh_ / 12, h_ = bhh_ % 12, gi_ = h_ >> 2, dil_ = 1 << (2 * gi_), \
        m_ = (gi_ == 0) ? p8_ : (gi_ == 1 ? (p8_ & 1) : 0), rp_ = (gi_ == 0) ? 0 : (gi_ == 1 ? (p8_ >> 1) : 2 * p8_); const size_t row0_ = (size_t)b_ * SEQ
    v4u kv[6], vv[6], qv[4];
    const int rsub = tid >> 3, pc = tid & 7;
#define AT_LOAD(it_) do { AT_DECODE(it_); \
        _Pragma("unroll") for (int i = 0; i < 6; ++i) { \
            const int tg_ = (gi_ < 2) ? 4 * m_ - 2 + i : ((i - 2) & 1), rr_ = (gi_ < 2) ? rp_ : rp_ + (i >= 4 ? 1 : 0); \
            if ((gi_ < 2) ? (tg_ >= 0) : (i >= 2)) { const bf16* kp = KV + ((size_t)(b_ * 12 + h_) * 2048 + rr_ * (2048 >> (2 * gi_)) + tg_ * 64 + rsub) * 128 + 8 * pc; \
                kv[i] = *(const v4u*)kp; vv[i] = *(const v4u*)(kp + 64); } \
            else { kv[i] = (v4u){0u, 0u, 0u, 0u}; vv[i] = (v4u){0u, 0u, 0u, 0u}; } } \
        _Pragma("unroll") for (int i = 0; i < 4; ++i) { const int R_ = 64 * i + rsub, hq_ = R_ >> 7, nq_ = (gi_ < 2) ? 2 * m_ + hq_ : 0, rq_ = (gi_ < 2) ? rp_ : rp_ + hq_; \
            qv[i] = *(const v4u*)(Q + (row0_ + (size_t)(nq_ * 128 + (R_ & 127)) * dil_ + rq_) * 768 + h_ * 64 + 8 * pc); } } while (0)
    AT_LOAD(0);
    for (int it = 0; it < 6; ++it) {
        AT_DECODE(it);
        const int h = h_, dil = dil_, r = (gi_ < 2) ? rp_ : rp_ + half, n = (gi_ < 2) ? 2 * m_ + half : 0; const size_t row0 = row0_;
        const size_t tokq = row0 + (size_t)(n * 128 + qi) * dil + r;
        __syncthreads();
        bf16x8 qr[4];
        {
#pragma unroll
            for (int i = 0; i < 4; ++i) *(LAS v4u*)(Ks + (64 * i + rsub) * 144 + pc * 16) = qv[i];
            __syncthreads();
#pragma unroll
            for (int d0 = 0; d0 < 4; ++d0) qr[d0] = *(const LAS bf16x8*)(Ks + (128 * half + qi) * 144 + (16 * d0 + 8 * hi) * 2);
            __syncthreads();
        }
        {
#pragma unroll
            for (int i = 0; i < 6; ++i) {
                *(LAS v4u*)(Ks + i * 8192 + pc * 1024 + ((rsub ^ (2 * pc)) * 16)) = kv[i];
                *(LAS v4u*)(Vs + i * 8192 + (pc >> 2) * 4096 + (rsub >> 4) * 1024 + (rsub & 15) * 64 + (pc & 3) * 16) = vv[i]; }
        }
        __syncthreads();
        if (it < 5) AT_LOAD(it + 1);
        const float cb = __builtin_amdgcn_exp2f(-8.f * (float)(h + 1) * (1.f / 12.f)) * (float)dil * LOG2E;
        const int smax = (n > 0) ? 128 : qi;
        float m = -INFINITY, lpart = 0.f;
        f32x16 o[2] = {{}, {}};
#pragma unroll 1
        for (int jj = 0; jj < 3; ++jj) {
            const int jt = a0 + jj;
            LAS const unsigned char* kb = Kb + jt * 8192 + hi * 1024;
            bf16x8 kf[8];
#pragma unroll
            for (int d0 = 0; d0 < 4; ++d0) { LAS const unsigned char* kp2 = kb + d0 * 2048 + ((r32 ^ (4 * d0 + 2 * hi)) * 16);
                kf[2 * d0] = *(const LAS bf16x8*)kp2; kf[2 * d0 + 1] = *(const LAS bf16x8*)(kp2 + 512); }
            f32x16 p0 = {}, p1 = {};
#pragma unroll
            for (int d0 = 0; d0 < 4; ++d0) { p0 = __builtin_amdgcn_mfma_f32_32x32x16_bf16(kf[2 * d0], qr[d0], p0, 0, 0, 0); p1 = __builtin_amdgcn_mfma_f32_32x32x16_bf16(kf[2 * d0 + 1], qr[d0], p1, 0, 0, 0); }
            const int sbase = qi + 128 - 64 * jt - 4 * hi;
            float tmax = -INFINITY;
#pragma unroll
            for (int rr = 0; rr < 16; ++rr) { const int st0 = sbase - ((rr & 3) + 8 * (rr >> 2)), st1 = st0 - 32;
                p0[rr] = ((unsigned)st0 <= (unsigned)smax) ? p0[rr] - cb * (float)st0 : -INFINITY;
                p1[rr] = ((unsigned)st1 <= (unsigned)smax) ? p1[rr] - cb * (float)st1 : -INFINITY;
                tmax = fmaxf(tmax, fmaxf(p0[rr], p1[rr])); }
            tmax = fmaxf(tmax, __shfl_xor(tmax, 32));
            const float mn = fmaxf(m, tmax), mu = (mn == -INFINITY) ? 0.f : mn;
            const float alpha = __builtin_amdgcn_exp2f(m - mu);
            float ps = 0.f;
#pragma unroll
            for (int rr = 0; rr < 16; ++rr) { p0[rr] = __builtin_amdgcn_exp2f(p0[rr] - mu); p1[rr] = __builtin_amdgcn_exp2f(p1[rr] - mu); ps += p0[rr] + p1[rr]; }
            lpart = lpart * alpha + ps; m = mn;
#pragma unroll
            for (int rr = 0; rr < 16; ++rr) { o[0][rr] *= alpha; o[1][rr] *= alpha; }
            bf16x8 paf[4];
#pragma unroll
            for (int ks = 0; ks < 4; ++ks) { const f32x16& pp = (ks >> 1) ? p1 : p0; const int bs = (ks & 1) * 8; v4u t4;
                t4.x = pg8::cvt_pk_bf16(pp[bs + 0], pp[bs + 1]); t4.y = pg8::cvt_pk_bf16(pp[bs + 2], pp[bs + 3]); t4.z = pg8::cvt_pk_bf16(pp[bs + 4], pp[bs + 5]); t4.w = pg8::cvt_pk_bf16(pp[bs + 6], pp[bs + 7]);
                paf[ks] = __builtin_bit_cast(bf16x8, t4); }
            LAS const unsigned char* vb = Vb + jt * 8192 + ((lane >> 4) & 1) * 32 + (lane & 3) * 8 + (4 * hi + ((lane & 15) >> 2)) * 64;
#pragma unroll
            for (int d0 = 0; d0 < 2; ++d0) { bf16x8 vfr[4];
#pragma unroll
                for (int ks = 0; ks < 4; ++ks) vfr[ks] = cat44(lds_tr(vb + d0 * 4096 + ks * 1024), lds_tr(vb + d0 * 4096 + ks * 1024 + 512));
#pragma unroll
                for (int ks = 0; ks < 4; ++ks) o[d0] = __builtin_amdgcn_mfma_f32_32x32x16_bf16(vfr[ks], paf[ks], o[d0], 0, 0, 0); }
        }
        const float lsum = lpart + __shfl_xor(lpart, 32);
        const float rl = 1.f / lsum;
        if (DRY) { asm volatile("" :: "v"(o[0][0] * rl), "v"(o[1][5] * rl), "v"(m), "v"(lsum)); continue; }
        bf16* op = Q + tokq * 768 + h * 64 + 8 * hi;
#pragma unroll
        for (int d0 = 0; d0 < 2; ++d0)
#pragma unroll
            for (int p = 0; p < 2; ++p) { const int qe = 2 * p, qo = 2 * p + 1;
                const unsigned ex = pg8::cvt_pk_bf16(o[d0][4 * qe] * rl, o[d0][4 * qe + 1] * rl), ey = pg8::cvt_pk_bf16(o[d0][4 * qe + 2] * rl, o[d0][4 * qe + 3] * rl);
                const unsigned ox = pg8::cvt_pk_bf16(o[d0][4 * qo] * rl, o[d0][4 * qo + 1] * rl), oy = pg8::cvt_pk_bf16(o[d0][4 * qo + 2] * rl, o[d0][4 * qo + 3] * rl);
                const auto sx = __builtin_amdgcn_permlane32_swap(ex, ox, false, false), sy = __builtin_amdgcn_permlane32_swap(ey, oy, false, false);
                const v4u val = {sx[0], sy[0], sx[1], sy[1]};
                *(v4u*)(op + 32 * d0 + 16 * p) = val; }
        if (hi == 0) LSE[tokq * 12 + h] = LN2 * (m + __builtin_amdgcn_logf(lsum));
    }
#undef AT_DECODE
#undef AT_LOAD
}
__device__ __forceinline__ void mixer_phase_a(Frame& F) {
    gla_prep<false>(F);
    __syncthreads();
    attn_units<false>(F);
}
__device__ __forceinline__ void mixer_phase_b(Frame& F) {
    gla_chain2<false>(F); }
__device__ __forceinline__ void combine_phase(Frame& F) {
    PHASE_LOCAL(F);
    const int gw = F.vcu * NWAVES + F.wave, lane = F.lane, hf = lane >> 5, l32 = lane & 31;
    const bf16* Qo = (const bf16*)(F.ws + WS_Q); const float* LSE = (const float*)(F.ws + WS_LSE); const float* SSQ = (const float*)(F.ws + WS_SSQ);
    bf16* GB = (bf16*)(F.ws + WS_GB); float* RQ = (float*)(F.ws + WS_RQ);
    for (int i0 = 0; i0 < 16; i0 += 4) {
        float l0[2], l1[2], l2[2]; v2u sq[2]; v4u ga[2], gb[2], gc[2];
#pragma unroll
        for (int q = 0; q < 2; ++q) { const size_t tok = (size_t)gw * 16 + i0 + 2 * q + hf; const int j = l32 >> 3;
            l0[q] = LSE[tok * 12 + j]; l1[q] = LSE[tok * 12 + 4 + j]; l2[q] = LSE[tok * 12 + 8 + j];
            const bf16* og_ = Qo + tok * 768 + 8 * l32;
            ga[q] = *(const v4u*)og_; gb[q] = *(const v4u*)(og_ + 256); gc[q] = *(const v4u*)(og_ + 512);
            sq[q] = *(const v2u*)(SSQ + tok * 64 + 2 * l32); }
#pragma unroll
        for (int q = 0; q < 2; ++q) { const size_t tok = (size_t)gw * 16 + i0 + 2 * q + hf;
            {
                const float mm = fmaxf(l0[q], fmaxf(l1[q], l2[q]));
                float w0 = __expf(l0[q] - mm), w1 = __expf(l1[q] - mm), w2 = __expf(l2[q] - mm); const float inv = 1.f / (w0 + w1 + w2); w0 *= inv; w1 *= inv; w2 *= inv;
                const unsigned av[4] = {ga[q].x, ga[q].y, ga[q].z, ga[q].w}, bv[4] = {gb[q].x, gb[q].y, gb[q].z, gb[q].w}, cv[4] = {gc[q].x, gc[q].y, gc[q].z, gc[q].w};
                unsigned o[4];
#pragma unroll
                for (int e = 0; e < 4; ++e) o[e] = pk2(w0 * bflo(av[e]) + w1 * bflo(bv[e]) + w2 * bflo(cv[e]), w0 * bfhi(av[e]) + w1 * bfhi(bv[e]) + w2 * bfhi(cv[e]));
                *(v4u*)(GB + tok * 2048 + 768 + 8 * l32) = (v4u){o[0], o[1], o[2], o[3]};
            }
            {
                float s = __uint_as_float(sq[q].x) + __uint_as_float(sq[q].y);
                s += __shfl_xor(s, 1); s += __shfl_xor(s, 2); s += __shfl_xor(s, 4);
                float rr[4];
#pragma unroll
                for (int hh = 0; hh < 4; ++hh) rr[hh] = 1.f / sqrtf(__shfl(s, (lane & 32) | (8 * hh)) * (1.f / 256.f) + EPS);
                if (l32 == 0) { float* rq = RQ + tok * 8;
                    *(f32x4*)rq = (f32x4){1.f / rr[0], rr[0] / rr[1], rr[1] / rr[2], rr[2] / rr[3]}; rq[4] = rr[3]; }
            }
        }
    }
}
#ifndef LAST_PHASE
#define LAST_PHASE 99
#endif
constexpr int LDS_BYTES = 163840;
__global__ void __launch_bounds__(NTHREADS, 2) mega_fwd(Args args) {
    extern __shared__ __attribute__((aligned(16))) unsigned char lds[];
    __builtin_assume(__builtin_amdgcn_workitem_id_y() == 0); __builtin_assume(__builtin_amdgcn_workitem_id_z() == 0);
#if USE_CG_SYNC
    cg::grid_group grid = cg::this_grid();
#endif
    Frame F;
    F.lds = (LAS unsigned char*)lds;
    F.wave = __builtin_amdgcn_readfirstlane((int)threadIdx.x >> 6); F.tid = 0; F.lane = 0;
    F.G = gridDim.x; { const int bx = blockIdx.x; F.vcu = (F.G % 8 == 0) ? (bx % 8) * (F.G / 8) + bx / 8 : bx; }
    F.in = args.in; F.out = args.out; F.ws = args.ws;
    unsigned char* ws = args.ws;
    const float* mod = (const float*)(ws + WS_MOD);
    bf16* U = (bf16*)(ws + WS_U);
    bf16* H1 = (bf16*)args.out;
    bf16* H2 = (bf16*)(ws + WS_GR);
    const int lo = args.ph_lo, hi = args.ph_hi;
#define IN(k) (lo <= (k) && (k) < hi && (k) <= LAST_PHASE)
    volatile LAS unsigned* MISC = (volatile LAS unsigned*)(F.lds + 147392);
    unsigned* barw = (unsigned*)(ws + WS_CTL);
    XcdBarrier bar; bar.bar = barw; bar.x = 0; bar.st = MISC;
    const bool multi = (hi - lo) > 1;
    if (multi) {
#if USE_CG_SYNC
        if (blockIdx.x == 0) for (int i = threadIdx.x; i < XCD_BAR_WORDS; i += NTHREADS) barw[i] = 0u;
#endif
        if (threadIdx.x < 2) MISC[threadIdx.x] = 0u;
    }
#define BARRIER_NOW() do { PHASE_LOCAL(F); xcd_barrier(bar, F.tid == 0); } while (0)
#define SEAM(k) do { if (IN(k) && IN((k) + 1)) { PHASE_LOCAL(F); xcd_barrier(bar, F.tid == 0); } } while (0)
#if !USE_CG_SYNC
    if (multi) { __syncthreads(); PHASE_LOCAL(F); bar = xcd_barrier_post(barw, MISC, F.tid == 0); }
#endif
    if (IN(0)) { p0_prologue(F); p0_mod(F); }
#if USE_CG_SYNC
    if (IN(0) && IN(1)) { grid.sync(); PHASE_LOCAL(F); bar = xcd_barrier_post(barw, MISC, F.tid == 0); }
#else
    SEAM(0);
#endif
    if (IN(1)) norm_phase<false>(F, args.in[I_X], args.in[I_GFFN1], 0, U);
    SEAM(1);
    if (IN(2)) { pg8::Gemm g{U, (const bf16*)(ws + WS_W13_1), T, 2 * DFF, D, D, D}; pg8::StaticOrder S; S.init(T, 2 * DFF, F.G, (int)blockIdx.x);
        pg8::EpiSwiGLU E{(bf16*)(ws + WS_HACT), DFF}; pg8::gemm_phase(F.lds, g, S, E, F.wave); }
    SEAM(2);
    if (IN(3)) { pg8::Gemm g{(const bf16*)(ws + WS_HACT), (const bf16*)(ws + WS_W2_1), T, D, DFF, DFF, DFF, 1}; pg8::StaticOrder S; S.init(T, D, F.G, (int)blockIdx.x);
        pg8::EpiResidual<false, true> E{args.in[I_X], H1, mod + 2 * D, 0.5f}; pg8::gemm_phase(F.lds, g, S, E, F.wave); }
    SEAM(3);
    if (IN(4)) norm_phase<true>(F, H1, args.in[I_GMIX], 3, U);
    SEAM(4);
    if (IN(5)) { pg8::Gemm g{U, (const bf16*)(ws + WS_WIN), T, N_PROJ1, D, D, D}; pg8::StaticOrder S; S.init(T, N_PROJ1, F.G, (int)blockIdx.x);
        pg8::EpiProj E{(bf16*)(ws + WS_Q), (bf16*)(ws + WS_KV), (bf16*)(ws + WS_GB), (bf16*)(ws + WS_GR), (bf16*)(ws + WS_GD), args.in[I_QNG], args.in[I_KNG], args.in[I_GONG]}; pg8::gemm_phase(F.lds, g, S, E, F.wave); }
    SEAM(5);
    if (IN(6)) { mixer_phase_a(F); if (multi) BARRIER_NOW(); else {   } if (multi) mixer_phase_b(F); }
    SEAM(6);
    bf16* SA = (bf16*)args.out + (size_t)T * D; bf16* SGG = (bf16*)(ws + WS_KV);
    if (IN(7)) { if (!multi) mixer_phase_b(F);
        const int cls = 0;
#pragma unroll 1
        for (int step = 0; step < 2; ++step) {
            if ((step ^ cls) == 0) combine_phase(F);
            else { pg8::Gemm g{U, (const bf16*)(ws + WS_WIN) + (size_t)N_PROJ1 * D, T, N_GATES, D, D, D}; pg8::StaticOrder S; S.init(T, N_GATES, F.G, (int)blockIdx.x);
                pg8::EpiGates E{SA, SGG}; pg8::gemm_phase(F.lds, g, S, E, F.wave); }
            __syncthreads(); }
    }
    SEAM(7);
    if (IN(9)) { pg8::Gemm g{(const bf16*)(ws + WS_GB) + 768, (const bf16*)(ws + WS_WB), T, D, 1280, 2048, 1280}; pg8::StaticOrder S; S.init(T, D, F.G, (int)blockIdx.x);
        pg8::EpiBranch E{(const float*)(ws + WS_RQ), (PG8_LAS float*)(F.lds + 147456), SA, SGG, U};
        pg8::gemm_phase(F.lds, g, S, E, F.wave); }
    SEAM(9);
    if (IN(10)) { pg8::Gemm g{U, (const bf16*)(ws + WS_WOUT), T, D, D, D, D};
        pg8::StaticOrder S; S.init(T, D, F.G, (int)blockIdx.x);
        pg8::EpiResidual<true, true> E{H1, H2, mod + 5 * D, 1.0f}; pg8::gemm_phase(F.lds, g, S, E, F.wave); }
    SEAM(10);
    if (IN(11)) norm_phase<true>(F, H2, args.in[I_GFFN2], 6, U);
    SEAM(11);
    if (IN(12)) { pg8::Gemm g{U, (const bf16*)(ws + WS_W13_2), T, 2 * DFF, D, D, D}; pg8::StaticOrder S; S.init(T, 2 * DFF, F.G, (int)blockIdx.x);
        pg8::EpiSwiGLU E{(bf16*)(ws + WS_HACT), DFF}; pg8::gemm_phase(F.lds, g, S, E, F.wave); }
    SEAM(12);
    if (IN(13)) { pg8::Gemm g{(const bf16*)(ws + WS_HACT), (const bf16*)(ws + WS_W2_2), T, D, DFF, DFF, DFF, 1}; pg8::StaticOrder S; S.init(T, D, F.G, (int)blockIdx.x);
        pg8::EpiResidual<true, false> E{H2, args.out, mod + 8 * D, 0.5f}; pg8::gemm_phase(F.lds, g, S, E, F.wave); }
#undef IN
#undef SEAM
}

#ifndef N_LAUNCHES
#define N_LAUNCHES 1
#endif
constexpr int N_PHASES = 14;
extern "C" void kernel_launch(void* const* d_in, const int* in_sizes, int n_in, void* d_out, int out_size, void* d_ws, size_t ws_size, hipStream_t stream) {
    static int grid = 0;
    if (grid == 0) {
        int dev = 0, cus = 0, per_cu = 0;
        if (n_in != 22 || out_size != T * D || ws_size < WS_END) { fprintf(stderr, "kernel_launch: unexpected shapes (n_in %d out %d ws %zu)\n", n_in, out_size, ws_size); grid = -1; return; }
        (void)hipGetDevice(&dev);
        (void)hipDeviceGetAttribute(&cus, hipDeviceAttributeMultiprocessorCount, dev);
        (void)hipFuncSetAttribute((const void*)mega_fwd, hipFuncAttributeMaxDynamicSharedMemorySize, LDS_BYTES);
        (void)hipOccupancyMaxActiveBlocksPerMultiprocessor(&per_cu, (const void*)mega_fwd, NTHREADS, LDS_BYTES);
        if (per_cu < 1) per_cu = 1;
        grid = cus * per_cu;
        if (grid > 256) grid = 256;
        if (grid != 256) fprintf(stderr, "kernel_launch: grid %d != 256\n", grid);
        (void)hipGetLastError();
    }
    if (grid < 0) return;
    Args a{};
    for (int i = 0; i < 22; ++i) a.in[i] = (const float*)d_in[i];
    a.out = (float*)d_out; a.ws = (unsigned char*)d_ws;
    if (N_LAUNCHES == 1) {
        a.ph_lo = 0; a.ph_hi = N_PHASES;
        void* kargs[] = {&a};
#if !USE_CG_SYNC
        (void)hipMemsetAsync((char*)d_ws + WS_CTL, 0, XCD_BAR_WORDS * 4, stream);
#endif
        hipError_t e = hipLaunchCooperativeKernel((void*)mega_fwd, dim3(grid), dim3(NTHREADS), kargs, LDS_BYTES, stream);
        if (e != hipSuccess) fprintf(stderr, "cooperative launch failed: %s (grid %d)\n", hipGetErrorString(e), grid);
    } else {
        for (int p = 0; p < N_PHASES; ++p) { a.ph_lo = p; a.ph_hi = p + 1; hipLaunchKernelGGL(mega_fwd, dim3(grid), dim3(NTHREADS), LDS_BYTES, stream, a); }
    }
}
```
